# Optimizing an MI355X kernel written in HIP

```python
import math
import jax, jax.numpy as jnp
from jax import lax
import numpy as np

D_MODEL = 2048
BATCH = 2
SEQ = 16384
DEPTH = 4
DEC_BATCH = 32
DEC_SEQ = 32
PAST_LEN = 2048

CHUNK = 64
N_MIXERS = 3
N_A = (DEPTH + 2) // 3
N_B = (DEPTH + 1) // 3
N_C = DEPTH // 3

SB_HEADS = 8
SB_HEAD_DIM = 128
SB_WIDTH = SB_HEADS * SB_HEAD_DIM
SB_QBLOCK = 128
SB_KBLOCK = 128
SWA_HEADS = 32
SWA_KV_HEADS = 4
SWA_HEAD_DIM = D_MODEL // SWA_HEADS
SWA_REP = SWA_HEADS // SWA_KV_HEADS
SWA_WIDTH = SWA_HEADS * SWA_HEAD_DIM
SWA_KV_WIDTH = SWA_KV_HEADS * SWA_HEAD_DIM
WINDOW = 128
WIN_CHUNKS = WINDOW // CHUNK
SSM_WIDTH = D_MODEL // 2
SSM_GROUP = 16
SSM_GROUPS = SSM_WIDTH // SSM_GROUP
SSM_STATE = 64
DT_MIN = 1e-3
DT_MAX = 1e-1

ALPHA = (2 * DEPTH) ** 0.25
BETA = (8 * DEPTH) ** -0.25
LN_EPS = 1e-5

kernel_name = "hybrid_stream_encoder_step"


def layer_norm(x, g, b):
    xf = x.astype(jnp.float32)
    mu = jnp.mean(xf, axis=-1, keepdims=True)
    xc = xf - mu
    var = jnp.mean(xc * xc, axis=-1, keepdims=True)
    return (xc * lax.rsqrt(var + LN_EPS) * g.astype(jnp.float32) + b.astype(jnp.float32)).astype(x.dtype)


def stick_breaking(q, k, v, q_pos, k_pos):
    z = jnp.einsum('bqhd,bnkhd->bhqnk', q, k).astype(jnp.float32) * (SB_HEAD_DIM ** -0.5)
    mask = k_pos[None, :, :] < q_pos[:, None, None]
    log_1mb = jnp.where(mask, jax.nn.log_sigmoid(-z), 0.0)
    tri = jnp.tril(jnp.ones((SB_KBLOCK, SB_KBLOCK), jnp.float32))
    r_in = jnp.einsum('bhqnk,kj->bhqnj', log_1mb, tri, precision=lax.Precision.HIGHEST)
    tot = r_in[..., 0]
    later = lax.cumsum(tot, axis=3, reverse=True) - tot
    w = jnp.where(mask, jnp.exp(z + r_in + later[..., None]), 0.0)
    return jnp.einsum('bhqnk,bnkhd->bqhd', w.astype(v.dtype), v)


def sb_project(x, w_in):
    q, k, v, g = jnp.split(x @ w_in, 4, axis=-1)
    hs = x.shape[:-1] + (SB_HEADS, SB_HEAD_DIM)
    return q.reshape(hs), k.reshape(hs), v.reshape(hs), g


def sb_prompt(x, w_in, w_out):
    b, s, _ = x.shape
    q, k, v, g = sb_project(x, w_in)
    outs = []
    for i in range(s // SB_QBLOCK):
        lo, hi = i * SB_QBLOCK, (i + 1) * SB_QBLOCK
        nk = hi // SB_KBLOCK
        kb = k[:, :hi].reshape(b, nk, SB_KBLOCK, SB_HEADS, SB_HEAD_DIM)
        vb = v[:, :hi].reshape(b, nk, SB_KBLOCK, SB_HEADS, SB_HEAD_DIM)
        q_pos = jnp.arange(lo, hi, dtype=jnp.int32)
        k_pos = jnp.arange(hi, dtype=jnp.int32).reshape(nk, SB_KBLOCK)
        outs.append(stick_breaking(q[:, lo:hi], kb, vb, q_pos, k_pos))
    o = jnp.concatenate(outs, axis=1).reshape(b, s, SB_WIDTH)
    return (o * jax.nn.silu(g)) @ w_out, k, v


def sb_sample(x, cache_k, cache_v, w_in, w_out):
    b, t, _ = x.shape
    past = cache_k.shape[1]
    q, k, v, g = sb_project(x, w_in)
    n = past + t
    n_pad = -(-n // SB_KBLOCK) * SB_KBLOCK
    nk = n_pad // SB_KBLOCK
    pad = ((0, 0), (0, n_pad - n), (0, 0), (0, 0))
    keys = jnp.pad(jnp.concatenate([cache_k.astype(k.dtype), k], axis=1), pad)
    vals = jnp.pad(jnp.concatenate([cache_v.astype(v.dtype), v], axis=1), pad)
    keys = keys.reshape(b, nk, SB_KBLOCK, SB_HEADS, SB_HEAD_DIM)
    vals = vals.reshape(b, nk, SB_KBLOCK, SB_HEADS, SB_HEAD_DIM)
    q_pos = past + jnp.arange(t, dtype=jnp.int32)
    k_pos = jnp.arange(n_pad, dtype=jnp.int32).reshape(nk, SB_KBLOCK)
    o = stick_breaking(q, keys, vals, q_pos, k_pos).reshape(b, t, SB_WIDTH)
    return (o * jax.nn.silu(g)) @ w_out, k, v


def alibi_slopes(n):
    return 2.0 ** (-8.0 * jnp.arange(1, n + 1, dtype=jnp.float32) / n)


def sink_attention(q, k, v, bias, valid, sinks):
    logits = jnp.einsum('bcqkrd,bcskd->bckrqs', q, k).astype(jnp.float32) * (SWA_HEAD_DIM ** -0.5) + bias
    logits = jnp.where(valid, logits, -jnp.inf)
    sink = jnp.broadcast_to(sinks.astype(jnp.float32)[:, :, None, None], logits.shape[:-1] + (1,))
    p = jax.nn.softmax(jnp.concatenate([logits, sink], axis=-1), axis=-1)[..., :-1]
    return jnp.einsum('bckrqs,bcskd->bcqkrd', p.astype(v.dtype), v)


def swa_project(x, w_in):
    q, k, v, g = jnp.split(x @ w_in, [SWA_WIDTH, SWA_WIDTH + SWA_KV_WIDTH, SWA_WIDTH + 2 * SWA_KV_WIDTH], axis=-1)
    lead = x.shape[:-1]
    q = q.reshape(lead + (SWA_KV_HEADS, SWA_REP, SWA_HEAD_DIM))
    k = k.reshape(lead + (SWA_KV_HEADS, SWA_HEAD_DIM))
    v = v.reshape(lead + (SWA_KV_HEADS, SWA_HEAD_DIM))
    return q, k, v, g


def swa_prompt(x, w_in, sinks, w_out):
    b, s, _ = x.shape
    nc = s // CHUNK
    span = (WIN_CHUNKS + 1) * CHUNK
    q, k, v, g = swa_project(x, w_in)

    def band(t):
        tp = jnp.pad(t, ((0, 0), (WIN_CHUNKS * CHUNK, 0), (0, 0), (0, 0)))
        tp = tp.reshape(b, nc + WIN_CHUNKS, CHUNK, SWA_KV_HEADS, SWA_HEAD_DIM)
        return jnp.concatenate([tp[:, i:i + nc] for i in range(WIN_CHUNKS + 1)], axis=2)

    qc = q.reshape(b, nc, CHUNK, SWA_KV_HEADS, SWA_REP, SWA_HEAD_DIM)
    qi = jnp.arange(CHUNK, dtype=jnp.int32)
    kj = jnp.arange(span, dtype=jnp.int32)
    dist = jnp.abs(qi[:, None] + WIN_CHUNKS * CHUNK - kj[None, :]).astype(jnp.float32)
    bias = -alibi_slopes(SWA_HEADS).reshape(SWA_KV_HEADS, SWA_REP)[:, :, None, None] * dist
    k_pos = jnp.arange(nc, dtype=jnp.int32)[:, None] * CHUNK - WIN_CHUNKS * CHUNK + kj[None, :]
    valid = (k_pos >= 0)[None, :, None, None, None, :]
    o = sink_attention(qc, band(k), band(v), bias, valid, sinks).reshape(b, s, SWA_WIDTH)
    win = min(WINDOW, s)
    return (o * jax.nn.silu(g)) @ w_out, k[:, s - win:], v[:, s - win:]


def swa_sample(x, cache_k, cache_v, w_in, sinks, w_out):
    b, t, _ = x.shape
    w = cache_k.shape[1]
    q, k, v, g = swa_project(x, w_in)
    keys = jnp.concatenate([cache_k.astype(k.dtype), k], axis=1)[:, None]
    vals = jnp.concatenate([cache_v.astype(v.dtype), v], axis=1)[:, None]
    k_rel = jnp.concatenate([jnp.arange(w, dtype=jnp.int32) - w, jnp.arange(t, dtype=jnp.int32)])
    dist = jnp.abs(jnp.arange(t, dtype=jnp.int32)[:, None] - k_rel[None, :]).astype(jnp.float32)
    bias = -alibi_slopes(SWA_HEADS).reshape(SWA_KV_HEADS, SWA_REP)[:, :, None, None] * dist
    o = sink_attention(q[:, None], keys, vals, bias, True, sinks).reshape(b, t, SWA_WIDTH)
    return (o * jax.nn.silu(g)) @ w_out, k, v


def ssm_discretize(a_re, a_im, log_dt, b_re, b_im):
    a_re = jnp.minimum(a_re.astype(jnp.float32), -1e-4)
    a_im = a_im.astype(jnp.float32)
    dt = jnp.exp(log_dt.astype(jnp.float32))[:, None]
    mag = jnp.exp(dt * a_re)
    lb_re = mag * jnp.cos(dt * a_im)
    lb_im = mag * jnp.sin(dt * a_im)
    n_re = lb_re - 1.0
    den = a_re * a_re + a_im * a_im
    f_re = ((n_re * a_re + lb_im * a_im) / den)[..., None]
    f_im = ((lb_im * a_re - n_re * a_im) / den)[..., None]
    br = b_re.astype(jnp.float32)
    bi = b_im.astype(jnp.float32)
    return lb_re, lb_im, f_re * br - f_im * bi, f_re * bi + f_im * br


def complex_linear_combine(e1, e2):
    a1r, a1i, b1r, b1i = e1
    a2r, a2i, b2r, b2i = e2
    return (a2r * a1r - a2i * a1i, a2r * a1i + a2i * a1r,
            a2r * b1r - a2i * b1i + b2r, a2r * b1i + a2i * b1r + b2i)


def s5_block(uc, h_re, h_im, lb_re, lb_im, bb_re, bb_im, c_re, c_im):
    bu_re = jnp.einsum('btgc,gpc->btgp', uc, bb_re)
    bu_im = jnp.einsum('btgc,gpc->btgp', uc, bb_im)
    lam_re = jnp.broadcast_to(lb_re, bu_re.shape)
    lam_im = jnp.broadcast_to(lb_im, bu_im.shape)
    pw_re, pw_im, s_re, s_im = lax.associative_scan(complex_linear_combine, (lam_re, lam_im, bu_re, bu_im), axis=1)
    hr = s_re + pw_re * h_re[:, None] - pw_im * h_im[:, None]
    hi = s_im + pw_re * h_im[:, None] + pw_im * h_re[:, None]
    y = jnp.einsum('btgp,gcp->btgc', hr, c_re) - jnp.einsum('btgp,gcp->btgc', hi, c_im)
    return y, hr[:, -1], hi[:, -1]


def s5_mixer(x, h_re, h_im, w_in, a_re, a_im, log_dt, b_re, b_im, c_re, c_im, d, w_glu, w_out):
    b, t, _ = x.shape
    u, g = jnp.split(x @ w_in, 2, axis=-1)
    lb_re, lb_im, bb_re, bb_im = ssm_discretize(a_re, a_im, log_dt, b_re, b_im)
    cr = c_re.astype(jnp.float32)
    ci = c_im.astype(jnp.float32)
    uf = u.astype(jnp.float32)
    blk = min(t, CHUNK)
    n_blk = t // blk
    ub = jnp.moveaxis(uf.reshape(b, n_blk, blk, SSM_GROUPS, SSM_GROUP), 1, 0)

    def step(h, uc):
        y, hr, hi = s5_block(uc, h[0], h[1], lb_re, lb_im, bb_re, bb_im, cr, ci)
        return (hr, hi), y

    (h_re, h_im), yb = lax.scan(step, (h_re.astype(jnp.float32), h_im.astype(jnp.float32)), ub)
    y = jnp.moveaxis(yb, 0, 1).reshape(b, t, SSM_WIDTH) + d.astype(jnp.float32) * uf
    y = jax.nn.gelu(y).astype(x.dtype)
    y = y * jax.nn.sigmoid(y @ w_glu)
    return (y * jax.nn.silu(g)) @ w_out, h_re, h_im


def setup_inputs(seed: int = 0) -> dict:
    key = jax.random.key(seed)
    ks = jax.random.split(key, 26)
    f32 = jnp.float32

    def nrm(k, shape, scale):
        return jax.random.normal(k, shape, f32) * scale

    win = min(WINDOW, PAST_LEN)
    n_in_a = 4 * SB_WIDTH
    n_in_b = SWA_WIDTH + 2 * SWA_KV_WIDTH + SWA_WIDTH
    n_in_c = 2 * SSM_WIDTH
    a_im = jnp.pi * jnp.arange(SSM_STATE, dtype=f32) + nrm(ks[17], (N_C, SSM_GROUPS, SSM_STATE), 0.01)
    return {
        "x_prompt": nrm(ks[0], (BATCH, SEQ, D_MODEL), 1.0),
        "x_sample": nrm(ks[1], (DEC_BATCH, DEC_SEQ, D_MODEL), 1.0),
        "cache_k_a": nrm(ks[2], (N_A, DEC_BATCH, PAST_LEN, SB_HEADS, SB_HEAD_DIM), 1.0),
        "cache_v_a": nrm(ks[3], (N_A, DEC_BATCH, PAST_LEN, SB_HEADS, SB_HEAD_DIM), 1.0),
        "cache_k_b": nrm(ks[4], (N_B, DEC_BATCH, win, SWA_KV_HEADS, SWA_HEAD_DIM), 1.0),
        "cache_v_b": nrm(ks[5], (N_B, DEC_BATCH, win, SWA_KV_HEADS, SWA_HEAD_DIM), 1.0),
        "state_re_c": nrm(ks[6], (N_C, DEC_BATCH, SSM_GROUPS, SSM_STATE), 0.1),
        "state_im_c": nrm(ks[7], (N_C, DEC_BATCH, SSM_GROUPS, SSM_STATE), 0.1),
        "ln_g": 1.0 + nrm(ks[8], (DEPTH, D_MODEL), 0.02),
        "ln_b": nrm(ks[9], (DEPTH, D_MODEL), 0.02),
        "w_in_a": nrm(ks[10], (N_A, D_MODEL, n_in_a), D_MODEL ** -0.5),
        "w_out_a": nrm(ks[11], (N_A, SB_WIDTH, D_MODEL), BETA * SB_WIDTH ** -0.5),
        "w_in_b": nrm(ks[12], (N_B, D_MODEL, n_in_b), D_MODEL ** -0.5),
        "sinks_b": nrm(ks[13], (N_B, SWA_KV_HEADS, SWA_REP), 1.0),
        "w_out_b": nrm(ks[14], (N_B, SWA_WIDTH, D_MODEL), BETA * SWA_WIDTH ** -0.5),
        "w_in_c": nrm(ks[15], (N_C, D_MODEL, n_in_c), D_MODEL ** -0.5),
        "a_re_c": -0.5 + nrm(ks[16], (N_C, SSM_GROUPS, SSM_STATE), 0.01),
        "a_im_c": a_im,
        "log_dt_c": jax.random.uniform(ks[18], (N_C, SSM_GROUPS), f32, math.log(DT_MIN), math.log(DT_MAX)),
        "b_re_c": nrm(ks[19], (N_C, SSM_GROUPS, SSM_STATE, SSM_GROUP), (2 * SSM_GROUP) ** -0.5),
        "b_im_c": nrm(ks[20], (N_C, SSM_GROUPS, SSM_STATE, SSM_GROUP), (2 * SSM_GROUP) ** -0.5),
        "c_re_c": nrm(ks[21], (N_C, SSM_GROUPS, SSM_GROUP, SSM_STATE), (2 * SSM_STATE) ** -0.5),
        "c_im_c": nrm(ks[22], (N_C, SSM_GROUPS, SSM_GROUP, SSM_STATE), (2 * SSM_STATE) ** -0.5),
        "d_c": nrm(ks[23], (N_C, SSM_WIDTH), 1.0),
        "w_glu_c": nrm(ks[24], (N_C, SSM_WIDTH, SSM_WIDTH), SSM_WIDTH ** -0.5),
        "w_out_c": nrm(ks[25], (N_C, SSM_WIDTH, D_MODEL), BETA * SSM_WIDTH ** -0.5),
    }


def reference(x_prompt, x_sample, cache_k_a, cache_v_a, cache_k_b, cache_v_b, state_re_c, state_im_c,
              ln_g, ln_b, w_in_a, w_out_a, w_in_b, sinks_b, w_out_b,
              w_in_c, a_re_c, a_im_c, log_dt_c, b_re_c, b_im_c, c_re_c, c_im_c, d_c, w_glu_c, w_out_c):
    xp, xs = x_prompt, x_sample
    ka_p, va_p, ka_s, va_s = [], [], [], []
    kb_p, vb_p, kb_s, vb_s = [], [], [], []
    hr_p, hi_p, hr_s, hi_s = [], [], [], []
    for i in range(DEPTH):
        j = i // N_MIXERS
        kind = i % N_MIXERS
        if kind == 0:
            yp, kp, vp = sb_prompt(xp, w_in_a[j], w_out_a[j])
            ys, kn, vn = sb_sample(xs, cache_k_a[j], cache_v_a[j], w_in_a[j], w_out_a[j])
            ka_p.append(kp); va_p.append(vp); ka_s.append(kn); va_s.append(vn)
        elif kind == 1:
            yp, kp, vp = swa_prompt(xp, w_in_b[j], sinks_b[j], w_out_b[j])
            ys, kn, vn = swa_sample(xs, cache_k_b[j], cache_v_b[j], w_in_b[j], sinks_b[j], w_out_b[j])
            kb_p.append(kp); vb_p.append(vp); kb_s.append(kn); vb_s.append(vn)
        else:
            z0 = jnp.zeros((xp.shape[0], SSM_GROUPS, SSM_STATE), jnp.float32)
            yp, hrp, hip = s5_mixer(xp, z0, z0, w_in_c[j], a_re_c[j], a_im_c[j], log_dt_c[j], b_re_c[j], b_im_c[j],
                                    c_re_c[j], c_im_c[j], d_c[j], w_glu_c[j], w_out_c[j])
            ys, hrs, his = s5_mixer(xs, state_re_c[j], state_im_c[j], w_in_c[j], a_re_c[j], a_im_c[j], log_dt_c[j],
                                    b_re_c[j], b_im_c[j], c_re_c[j], c_im_c[j], d_c[j], w_glu_c[j], w_out_c[j])
            hr_p.append(hrp); hi_p.append(hip); hr_s.append(hrs); hi_s.append(his)
        xp = layer_norm(ALPHA * xp + yp, ln_g[i], ln_b[i])
        xs = layer_norm(ALPHA * xs + ys, ln_g[i], ln_b[i])
    return (xp, xs,
            jnp.stack(ka_p), jnp.stack(va_p), jnp.stack(ka_s), jnp.stack(va_s),
            jnp.stack(kb_p), jnp.stack(vb_p), jnp.stack(kb_s), jnp.stack(vb_s),
            jnp.stack(hr_p), jnp.stack(hi_p), jnp.stack(hr_s), jnp.stack(hi_s))
```

```cpp
#include <hip/hip_runtime.h>
#include <cstdio>
#include <cstdint>
namespace pg8 {
#define PG8_LAS __attribute__((address_space(3)))
typedef unsigned short bf16_t;
typedef short bf16x8 __attribute__((ext_vector_type(8)));
typedef float f32x4 __attribute__((ext_vector_type(4)));
typedef unsigned u32x4 __attribute__((ext_vector_type(4)));
constexpr int BM = 256, BK = 64, HALF = 128, HTB = HALF * BK * 2  , STAGE_BYTES = 8 * HTB, NXCD = 8, WGM = 8;

__host__ __device__ __forceinline__ int lds_byte(int r, int c) { const int st = (r >> 4) * 2 + (c >> 5), rr = r & 15, cc = c & 31, ob = rr * 64 + cc * 2; return st * 1024 + (ob ^ (((ob >> 9) & 1) << 5)); }
__host__ __device__ __forceinline__ void stage_rc(int b, int& R, int& C) { const int st = b / 1024, sb = b % 1024, swz = sb ^ (((sb >> 9) & 1) << 5); R = (st >> 1) * 16 + swz / 64; C = (st & 1) * 32 + (swz % 64) / 2; }
__host__ __device__ __forceinline__ int perm32(int rho) { const int n = rho >> 4, i = rho & 15; return 8 * (i >> 2) + 4 * n + (i & 3); }

struct Unit { int pm, pn; };
struct Gemm { const bf16_t* A; const bf16_t* Bt; int M, N, K; };

struct StaticOrder {
    int nM, nN, nwg, G, c;
    __host__ __device__ void init(int M, int N, int G_, int c_) { nM = M / BM; nN = N / BM; nwg = nM * nN; G = G_; c = c_; }
    __host__ __device__ bool next(int i, Unit& u) const {
        const long L = (long)i * G + c; if (L >= nwg) return false;
        int wgid = (int)L; { const int q = nwg / NXCD, r = nwg % NXCD, xcd = wgid % NXCD, off = wgid / NXCD; wgid = (xcd < r ? xcd * (q + 1) : r * (q + 1) + (xcd - r) * q) + off; }
        const int nig = WGM * nN, gid = wgid / nig, fm = gid * WGM, gsz = (nM - fm) < WGM ? (nM - fm) : WGM;
        u.pm = fm + ((wgid % nig) % gsz); u.pn = (wgid % nig) / gsz; return true;
    }
    __device__ __forceinline__ void a_ready(const Unit&) const {}
    __device__ __forceinline__ void done(const Unit&) const {}
};

__device__ __forceinline__ unsigned cvt_pk_bf16(float lo, float hi) { unsigned r; asm volatile("v_cvt_pk_bf16_f32 %0, %1, %2" : "=v"(r) : "v"(lo), "v"(hi)); return r; }
typedef float f32x2 __attribute__((ext_vector_type(2)));
__device__ __forceinline__ f32x2 gelu_pk(f32x2 v) {
    const f32x2 av = __builtin_elementwise_abs(v), d = av * 0.2316418882f + 1.0f;
    f32x2 t; t.x = __builtin_amdgcn_rcpf(d.x); t.y = __builtin_amdgcn_rcpf(d.y);
    f32x2 q = t * 0.5307027145f + (-0.7265760135f); q = q * t + 0.7107068705f; q = q * t + (-0.142248368f); q = q * t + 0.127414796f; q = q * t;
    const f32x2 s = (v * v) * (-0.72134752044f);
    f32x2 e; e.x = __builtin_amdgcn_exp2f(s.x); e.y = __builtin_amdgcn_exp2f(s.y);
    const f32x2 m = v * (q * e), r = v - m;
    f32x2 o; o.x = v.x < 0.f ? m.x : r.x; o.y = v.y < 0.f ? m.y : r.y; return o;
}

template <int ACT  > struct EpiBf16 {
    static constexpr bool PERM = true, AFTER_DRAIN = false; static_assert(ACT == 0 || ACT == 1, "EpiBf16: ACT is 0 (none) or 1 (gelu_pk)");
    bf16_t* O; int ldc; const float* bias; int split_cols; size_t split_stride; float scale0;
    __device__ __forceinline__ void operator()(const f32x4 (&acc)[2][2][4][2], const Unit& u, int wr, int wc, int fr, int fq) const {
        const int row0 = u.pm * BM + wr * 64 + fr; int colt = u.pn * BM; bf16_t* base = O;
        float sc = 1.f; if (split_cols) { const int t = colt / split_cols; base += (size_t)t * split_stride; colt -= t * split_cols; if (t == 0) sc = scale0; }
        const int col0 = colt + wc * 32 + 8 * fq, bcol0 = u.pn * BM + wc * 32 + 8 * fq;
        f32x4 bv[2][2];
#pragma unroll
        for (int bj = 0; bj < 2; ++bj)
#pragma unroll
            for (int n = 0; n < 2; ++n) bv[bj][n] = bias ? *(const f32x4*)(bias + bcol0 + bj * HALF + 4 * n) : (f32x4){0.f, 0.f, 0.f, 0.f};
#pragma unroll
        for (int ai = 0; ai < 2; ++ai)
#pragma unroll
            for (int m = 0; m < 4; ++m) { bf16_t* rowp = base + (size_t)(row0 + ai * HALF + m * 16) * ldc + col0;
#pragma unroll
                for (int bj = 0; bj < 2; ++bj) { f32x4 v0 = acc[ai][bj][m][0] + bv[bj][0], v1 = acc[ai][bj][m][1] + bv[bj][1];
                    if (ACT == 1) { f32x2 a = gelu_pk((f32x2){v0[0], v0[1]}), b = gelu_pk((f32x2){v0[2], v0[3]}), c = gelu_pk((f32x2){v1[0], v1[1]}), d = gelu_pk((f32x2){v1[2], v1[3]});
                        v0 = (f32x4){a.x, a.y, b.x, b.y}; v1 = (f32x4){c.x, c.y, d.x, d.y}; }
                    v0 = v0 * sc; v1 = v1 * sc; u32x4 w; w.x = cvt_pk_bf16(v0[0], v0[1]); w.y = cvt_pk_bf16(v0[2], v0[3]); w.z = cvt_pk_bf16(v1[0], v1[1]); w.w = cvt_pk_bf16(v1[2], v1[3]);
                    *(u32x4*)(rowp + bj * HALF) = w; } }
    }
};

template <class Epi, class Sched, bool ALIGN_EPI = false, bool SP2 = false>
__device__ __forceinline__ void gemm_phase(PG8_LAS unsigned char* lds, const Gemm g, const Sched& S, const Epi& E) {
    const int tid = threadIdx.x, wid = __builtin_amdgcn_readfirstlane(tid >> 6), lane = tid & 63, wr = wid >> 2, wc = wid & 3, fr = lane & 15, fq = lane >> 4;
    const int K = g.K, nt = K / BK;
    unsigned voffA[2], voffB[2];
#pragma unroll
    for (int i = 0; i < 2; ++i) { int R, C; stage_rc(tid * 16 + i * 8192, R, C); const int Rb = Epi::PERM ? ((R & ~31) + perm32(R & 31)) : R;
        voffA[i] = (unsigned)(R * K + C) * 2u; voffB[i] = (unsigned)(Rb * K + C) * 2u; }
    const size_t kstep = (size_t)(BK * 2);
    const size_t hstep = (size_t)HALF * K * 2;
    const size_t tstep = 2 * hstep;
    const unsigned ldsw = (unsigned)wid * 1024u;
    const int aoff = lds_byte(wr * 64 + fr, fq * 8), boff = lds_byte(wc * 32 + fr, fq * 8);
#define PG8_SA(b, h) (((b) * 2 + (h)) * HTB)
#define PG8_SB(b, h) ((4 + (b) * 2 + (h)) * HTB)
#define PG8_STAGE(bufoff, gbase, voff) do { _Pragma("unroll") for (int _i = 0; _i < 2; ++_i) \
        __builtin_amdgcn_global_load_lds((const unsigned*)((const char*)(gbase) + (voff)[_i]), (PG8_LAS unsigned*)(lds + (bufoff) + ldsw + _i * 8192), 16, 0, 0); } while (0)
#define PG8_LDA(dst, b, h) do { _Pragma("unroll") for (int m = 0; m < 4; ++m) _Pragma("unroll") for (int k = 0; k < 2; ++k) dst[m][k] = *(const PG8_LAS bf16x8*)(lds + PG8_SA(b, h) + aoff + m * 2048 + k * 1024); } while (0)
#define PG8_LDB(dst, b, h) do { _Pragma("unroll") for (int n = 0; n < 2; ++n) _Pragma("unroll") for (int k = 0; k < 2; ++k) dst[n][k] = *(const PG8_LAS bf16x8*)(lds + PG8_SB(b, h) + boff + n * 2048 + k * 1024); } while (0)
#define PG8_MMA(ai, bj, At, Bt) do { __builtin_amdgcn_s_setprio(1); _Pragma("unroll") for (int m = 0; m < 4; ++m) _Pragma("unroll") for (int n = 0; n < 2; ++n) _Pragma("unroll") for (int k = 0; k < 2; ++k) \
        acc[ai][bj][m][n] = __builtin_amdgcn_mfma_f32_16x16x32_bf16(Bt[n][k], At[m][k], acc[ai][bj][m][n], 0, 0, 0); __builtin_amdgcn_s_setprio(0); } while (0)
#define PG8_WAIT_V(n) asm volatile("s_waitcnt vmcnt(" #n ")" ::: "memory")
#define PG8_WAIT_L(n) asm volatile("s_waitcnt lgkmcnt(" #n ")" ::: "memory")
#define PG8_BAR __builtin_amdgcn_s_barrier()
#define PG8_SCHED __builtin_amdgcn_sched_barrier(0)
    Unit cur, nxt; int ui = 0;
    if (!S.next(0, cur)) return;
    f32x4 acc[2][2][4][2];
#pragma unroll
    for (int a = 0; a < 2; ++a)
#pragma unroll
        for (int b = 0; b < 2; ++b)
#pragma unroll
            for (int m = 0; m < 4; ++m)
#pragma unroll
                for (int n = 0; n < 2; ++n) acc[a][b][m][n] = (f32x4){0.f, 0.f, 0.f, 0.f};
    bf16x8 At[4][2], B0[2][2], B1[2][2];
    const char* cA = (const char*)g.A + (size_t)cur.pm * tstep; const char* cB = (const char*)g.Bt + (size_t)cur.pn * tstep;
    S.a_ready(cur);
    if constexpr (SP2) {
        PG8_STAGE(PG8_SB(0, 0), cB, voffB); PG8_STAGE(PG8_SB(0, 1), cB + hstep, voffB); PG8_STAGE(PG8_SA(0, 0), cA, voffA); PG8_STAGE(PG8_SA(0, 1), cA + hstep, voffA);
        if (wr == 1) PG8_BAR;
        PG8_WAIT_V(2); PG8_BAR;
        PG8_STAGE(PG8_SB(1, 0), cB + kstep, voffB); PG8_STAGE(PG8_SA(1, 0), cA + kstep, voffA); PG8_STAGE(PG8_SB(1, 1), cB + hstep + kstep, voffB);
        PG8_WAIT_V(6); PG8_BAR;
    } else {
        PG8_STAGE(PG8_SB(0, 0), cB, voffB); PG8_STAGE(PG8_SA(0, 0), cA, voffA); PG8_STAGE(PG8_SB(0, 1), cB + hstep, voffB); PG8_STAGE(PG8_SA(0, 1), cA + hstep, voffA);
        if (wr == 1) PG8_BAR;
        PG8_WAIT_V(4); PG8_BAR;
        PG8_STAGE(PG8_SB(1, 0), cB + kstep, voffB); PG8_STAGE(PG8_SA(1, 0), cA + kstep, voffA); PG8_STAGE(PG8_SB(1, 1), cB + hstep + kstep, voffB);
        PG8_WAIT_V(6); PG8_BAR;
    }
    for (;;) {
        const bool has_next = S.next(ui + 1, nxt);
        const char* nA = has_next ? (const char*)g.A + (size_t)nxt.pm * tstep : cA; const char* nB = has_next ? (const char*)g.Bt + (size_t)nxt.pn * tstep : cB;
        for (int t = 0; t < nt; t += 2) {
            const bool last = (t == nt - 2);
            const char* a1 = cA + (size_t)(t + 1) * kstep;
            const char* a2 = last ? nA : cA + (size_t)(t + 2) * kstep; const char* b2 = last ? nB : cB + (size_t)(t + 2) * kstep;
            const char* a3 = a2 + kstep; const char* b3 = b2 + kstep;
            if (last && has_next) S.a_ready(nxt);
            if constexpr (SP2) {
            PG8_LDB(B0, 0, 0); PG8_LDB(B1, 0, 1); PG8_SCHED; PG8_LDA(At, 0, 0); PG8_STAGE(PG8_SA(1, 1), a1 + hstep, voffA);
            PG8_WAIT_V(8); PG8_WAIT_L(0); PG8_BAR; PG8_MMA(0, 0, At, B0); PG8_MMA(0, 1, At, B1); PG8_BAR; PG8_SCHED;
            PG8_LDA(At, 0, 1); PG8_STAGE(PG8_SB(0, 0), b2, voffB); PG8_STAGE(PG8_SB(0, 1), b2 + hstep, voffB); PG8_STAGE(PG8_SA(0, 0), a2, voffA);
            PG8_WAIT_V(8); PG8_WAIT_L(0); PG8_BAR; PG8_MMA(1, 0, At, B0); PG8_MMA(1, 1, At, B1); PG8_BAR; PG8_SCHED;
            PG8_LDB(B0, 1, 0); PG8_LDB(B1, 1, 1); PG8_SCHED; PG8_LDA(At, 1, 0); PG8_STAGE(PG8_SA(0, 1), a2 + hstep, voffA);
            PG8_WAIT_V(8); PG8_WAIT_L(0); PG8_BAR; PG8_MMA(0, 0, At, B0); PG8_MMA(0, 1, At, B1); PG8_BAR; PG8_SCHED;
            PG8_LDA(At, 1, 1); PG8_STAGE(PG8_SB(1, 0), b3, voffB); PG8_STAGE(PG8_SB(1, 1), b3 + hstep, voffB); PG8_STAGE(PG8_SA(1, 0), a3, voffA);
            PG8_WAIT_V(8); PG8_WAIT_L(0); PG8_BAR; PG8_MMA(1, 0, At, B0); PG8_MMA(1, 1, At, B1); PG8_BAR; PG8_SCHED;
            } else {
            PG8_LDB(B0, 0, 0); PG8_SCHED; PG8_LDA(At, 0, 0); PG8_STAGE(PG8_SA(1, 1), a1 + hstep, voffA);
            PG8_WAIT_L(8); PG8_BAR; PG8_WAIT_L(0); PG8_MMA(0, 0, At, B0); PG8_BAR; PG8_SCHED;
            PG8_LDB(B1, 0, 1); PG8_STAGE(PG8_SB(0, 0), b2, voffB);
            PG8_BAR; PG8_WAIT_L(0); PG8_MMA(0, 1, At, B1); PG8_BAR;
            PG8_LDA(At, 0, 1); PG8_STAGE(PG8_SA(0, 0), a2, voffA);
            PG8_BAR; PG8_WAIT_L(0); PG8_MMA(1, 0, At, B0); PG8_BAR; PG8_SCHED;
            PG8_STAGE(PG8_SB(0, 1), b2 + hstep, voffB);
            PG8_WAIT_V(6); PG8_BAR; PG8_MMA(1, 1, At, B1); PG8_BAR;
            PG8_LDB(B0, 1, 0); PG8_SCHED; PG8_LDA(At, 1, 0); PG8_STAGE(PG8_SA(0, 1), a2 + hstep, voffA);
            PG8_WAIT_L(8); PG8_BAR; PG8_WAIT_L(0); PG8_MMA(0, 0, At, B0); PG8_BAR; PG8_SCHED;
            PG8_LDB(B1, 1, 1); PG8_STAGE(PG8_SB(1, 0), b3, voffB);
            PG8_BAR; PG8_WAIT_L(0); PG8_MMA(0, 1, At, B1); PG8_BAR;
            PG8_LDA(At, 1, 1); PG8_STAGE(PG8_SA(1, 0), a3, voffA);
            PG8_BAR; PG8_WAIT_L(0); PG8_MMA(1, 0, At, B0); PG8_BAR; PG8_SCHED;
            PG8_STAGE(PG8_SB(1, 1), b3 + hstep, voffB);
            PG8_WAIT_V(6); PG8_BAR; PG8_MMA(1, 1, At, B1); PG8_BAR;
            }
        }
        if constexpr (ALIGN_EPI) { if (wr == 0) PG8_BAR; }
        if constexpr (!Epi::AFTER_DRAIN) { E(acc, cur, wr, wc, fr, fq); S.done(cur); }
        if (!has_next) break;
#pragma unroll
        for (int a = 0; a < 2; ++a)
#pragma unroll
            for (int b = 0; b < 2; ++b)
#pragma unroll
                for (int m = 0; m < 4; ++m)
#pragma unroll
                    for (int n = 0; n < 2; ++n) acc[a][b][m][n] = (f32x4){0.f, 0.f, 0.f, 0.f};
        cur = nxt; cA = nA; cB = nB; ++ui;
        if constexpr (ALIGN_EPI) { if (wr == 1) PG8_BAR; }
    }
    PG8_WAIT_V(0);
    if constexpr (!ALIGN_EPI) { if (wr == 0) PG8_BAR; }
    PG8_BAR;
    if constexpr (Epi::AFTER_DRAIN) { E.fused(acc, cur, wr, wc, fr, fq, lds, wid, lane); S.done(cur); }
#undef PG8_SA
#undef PG8_SB
#undef PG8_STAGE
#undef PG8_LDA
#undef PG8_LDB
#undef PG8_MMA
#undef PG8_WAIT_V
#undef PG8_WAIT_L
#undef PG8_BAR
#undef PG8_SCHED
}
}
#define GAS __attribute__((address_space(1)))
#define LAS __attribute__((address_space(3)))
typedef unsigned short bf16;
typedef unsigned v4u __attribute__((ext_vector_type(4)));
typedef float f32x4 __attribute__((ext_vector_type(4)));
typedef short bf16x8 __attribute__((ext_vector_type(8)));
typedef GAS unsigned gu32;
typedef GAS unsigned long long gu64;
#define RLX_AGENT __ATOMIC_RELAXED, __HIP_MEMORY_SCOPE_AGENT
#define LDS_WAIT() asm volatile("s_waitcnt lgkmcnt(0)" ::: "memory")
#define VM_WAIT() asm volatile("s_waitcnt vmcnt(0)" ::: "memory")
__device__ __forceinline__ unsigned long long rt() { return __builtin_amdgcn_s_memrealtime(); }
__device__ __forceinline__ unsigned f2bf(float f) { unsigned u = __builtin_bit_cast(unsigned, f); return (u + 0x7fffu + ((u >> 16) & 1u)) >> 16; }
__device__ __forceinline__ unsigned pk2(float lo, float hi) { return f2bf(lo) | (f2bf(hi) << 16); }

#define XB_TMO      128
#define XB_XCNT(j)  (256  + 64 * (j))
#define XB_XSUB(j)  (1280 + 64 * (j))
#define XB_XGEN(j)  (2304 + 64 * (j))
#define XB_TOP      3328
#define XB_TOPGEN   3392
#define XCD_BAR_WORDS 3456
#define XB_SPIN_CAP (1u << 18)

__device__ __forceinline__ unsigned xb_ld(unsigned* p)              { return __hip_atomic_load(p, __ATOMIC_RELAXED, __HIP_MEMORY_SCOPE_AGENT); }
__device__ __forceinline__ unsigned xb_add(unsigned* p, unsigned v) { return __hip_atomic_fetch_add(p, v, __ATOMIC_RELAXED, __HIP_MEMORY_SCOPE_AGENT); }
__device__ __forceinline__ unsigned xb_xcc_id() { return (unsigned)__builtin_amdgcn_s_getreg((3 << 11) | 20) & 0xFu; }
#define XB_SPIN(cond, bar) do { unsigned _sp = 0; while (cond) { __builtin_amdgcn_s_sleep(1); \
    if ((++_sp & 255u) == 0u) { if (xb_ld(&(bar)[XB_TMO])) break; if (_sp > XB_SPIN_CAP) { atomicAdd(&(bar)[XB_TMO], 1u); break; } } } } while (0)

struct XcdBarrier {
    unsigned* bar; unsigned x;
    volatile LAS unsigned* st;
};

__device__ __forceinline__ XcdBarrier xcd_barrier_post(unsigned* bar, volatile LAS unsigned* st) {
    XcdBarrier b; b.bar = bar; b.x = xb_xcc_id(); b.st = st;
    if (threadIdx.x == 0) (void)xb_add(&bar[XB_XCNT(b.x)], 1u);
    return b;
}
__device__ __forceinline__ void xcd_barrier_complete(unsigned* bar, unsigned x, unsigned& nloc, unsigned& nx) {
    const unsigned G = gridDim.x * gridDim.y * gridDim.z;
    unsigned sum, cnt, mine, sp = 0u;
    for (;;) {
        sum = 0u; cnt = 0u; mine = 0u;
#pragma unroll
        for (unsigned j = 0; j < 16; ++j) { const unsigned c = xb_ld(&bar[XB_XCNT(j)]); sum += c; cnt += (c > 0u) ? 1u : 0u; mine = (j == x) ? c : mine; }
        if (sum == G) break;
        __builtin_amdgcn_s_sleep(1);
        if ((++sp & 255u) == 0u) { if (xb_ld(&bar[XB_TMO])) break; if (sp > XB_SPIN_CAP) { atomicAdd(&bar[XB_TMO], 1u); break; } }
    }
    nloc = mine > 0u ? mine : 1u; nx = cnt > 0u ? cnt : 1u;
}

__device__ __forceinline__ void xcd_barrier(const XcdBarrier& b) {
    asm volatile("s_waitcnt vmcnt(0)" ::: "memory");
    __syncthreads();
    if (threadIdx.x == 0) {
        unsigned* bar = b.bar;
        __builtin_amdgcn_s_waitcnt(0);
        unsigned nloc = b.st[0], nx = b.st[1];
        if (nloc == 0u) { xcd_barrier_complete(bar, b.x, nloc, nx); b.st[0] = nloc; b.st[1] = nx; }
        const unsigned old = xb_add(&bar[XB_XSUB(b.x)], 1u);
        const unsigned gen = old / nloc;
        if (old + 1u == (gen + 1u) * nloc) {
            __builtin_amdgcn_fence(__ATOMIC_RELEASE, "agent");
            asm volatile("s_waitcnt vmcnt(0)" ::: "memory");
            const unsigned og = xb_add(&bar[XB_TOP], 1u);
            const unsigned tg = og / nx;
            if (og + 1u == (tg + 1u) * nx) xb_add(&bar[XB_TOPGEN], 1u);
            else XB_SPIN(xb_ld(&bar[XB_TOPGEN]) == tg, bar);
            __builtin_amdgcn_fence(__ATOMIC_ACQUIRE, "agent");
            xb_add(&bar[XB_XGEN(b.x)], 1u);
            asm volatile("s_waitcnt vmcnt(0)" ::: "memory");
        } else {
            XB_SPIN(xb_ld(&bar[XB_XGEN(b.x)]) == gen, bar);
            __builtin_amdgcn_fence(__ATOMIC_ACQUIRE, "agent");
            asm volatile("s_waitcnt vmcnt(0)" ::: "memory");
        }
    }
    __syncthreads();
}

constexpr int NWAVES = 8;
constexpr int DM = 2048, SEQ = 16384, NBATCH = 2, MP = NBATCH * SEQ, DECB = 32, DECS = 32, MS = DECB * DECS, M = MP + MS, PAST = 2048;
constexpr int NPM = M / 256, NPM_P = MP / 256;
constexpr float ALPHA = 1.6817928305074290f;
constexpr float LN_EPS = 1e-5f;
constexpr float SB_SCALE = 0.08838834764831845f;
constexpr float SB_CUT = -104.0f;
constexpr size_t O_YP = 0, O_YS = O_YP + (size_t)MP * DM, O_KAP = O_YS + (size_t)MS * DM, O_VAP = O_KAP + 2ull * MP * 1024, O_KAS = O_VAP + 2ull * MP * 1024,
    O_VAS = O_KAS + 2ull * MS * 1024, O_KBP = O_VAS + 2ull * MS * 1024, O_VBP = O_KBP + 2ull * 128 * 256, O_KBS = O_VBP + 2ull * 128 * 256, O_VBS = O_KBS + (size_t)MS * 256,
    O_HRP = O_VBS + (size_t)MS * 256, O_HIP = O_HRP + 2 * 64 * 64, O_HRS = O_HIP + 2 * 64 * 64, O_HIS = O_HRS + 32 * 64 * 64, O_END = O_HIS + 32 * 64 * 64;
constexpr size_t MiB = 1u << 20;
constexpr size_t WS_CTL = 0, CTL_ZERO_BYTES = 1 * MiB;
constexpr size_t WS_SSMC = 1 * MiB;
constexpr size_t WS_WINA0 = 2 * MiB, WS_WINA1 = 18 * MiB, WS_WOUTA0 = 34 * MiB, WS_WOUTA1 = 38 * MiB, WS_WINB = 42 * MiB, WS_WOUTB = 60 * MiB, WS_WINC = 68 * MiB, WS_WGLU = 76 * MiB, WS_WOUTC = 78 * MiB;
constexpr size_t WS_XB = 96 * MiB;
constexpr size_t WS_XF = 256 * MiB;
constexpr size_t WS_PROJ = 520 * MiB;
constexpr size_t WS_AO = 832 * MiB;
constexpr size_t WS_AOC = 900 * MiB;
constexpr size_t WS_SEND = 968 * MiB, WS_HIN = 984 * MiB, WS_END = 1000 * MiB;
constexpr int CW_TMO = 0, CW_CODE = 1, CW_BAR = 4096;
constexpr int RING_OFF = 0, RING_BYTES = 131072, LDSCTL_OFF = RING_BYTES, MISC_OFF = LDSCTL_OFF + 320, LDS_BYTES = 147456;

struct Frame {
    LAS unsigned char* lds;
    volatile LAS unsigned* MISC;
    gu32* ctl;
    int tid, lane, wave;
    int vcu, G;
};
typedef float f32x2v __attribute__((ext_vector_type(2)));
__device__ __forceinline__ float bflo(unsigned v) { return __uint_as_float(v << 16); }
__device__ __forceinline__ float bfhi(unsigned v) { return __uint_as_float(v & 0xffff0000u); }
__device__ __forceinline__ float wave_sum(float v) {
#pragma unroll
    for (int o = 1; o < 64; o <<= 1) v += __shfl_xor(v, o);
    return v;
}
__device__ __forceinline__ float wave_max(float v) {
#pragma unroll
    for (int o = 1; o < 64; o <<= 1) v = fmaxf(v, __shfl_xor(v, o));
    return v;
}
__device__ __forceinline__ float silu_f(float g) { return g / (1.0f + __expf(-g)); }
__device__ __forceinline__ float gelu_tanh_f(float x) { const float a = 0.7978845608028654f * (x + 0.044715f * x * x * x); const float e = __expf(2.0f * a); return 0.5f * x * (2.0f - 2.0f / (1.0f + e)); }

__device__ __forceinline__ void p0_transpose_item(const float* W, int K, int N, bf16* WT, LAS float* scr, int item, int lane) {
    const int nblk = N / 32, kb = item / nblk, nb = item % nblk, k0 = 64 * kb, n0 = 32 * nb;
#pragma unroll 8
    for (int i = 0; i < 32; ++i) { const int kk = 2 * i + (lane >> 5); scr[kk * 33 + (lane & 31)] = W[(size_t)(k0 + kk) * N + n0 + (lane & 31)]; }
    LDS_WAIT(); asm volatile("" ::: "memory");
    const int c = lane & 7;
#pragma unroll
    for (int j = 0; j < 4; ++j) { const int n = (lane >> 3) + 8 * j; const LAS float* s = scr + (8 * c) * 33 + n;
        v4u o; o.x = pk2(s[0 * 33], s[1 * 33]); o.y = pk2(s[2 * 33], s[3 * 33]); o.z = pk2(s[4 * 33], s[5 * 33]); o.w = pk2(s[6 * 33], s[7 * 33]);
        *(GAS v4u*)(WT + (size_t)(n0 + n) * K + k0 + 8 * c) = o; }
    LDS_WAIT(); asm volatile("" ::: "memory");
}

struct Ptrs {
    const float* in[26]; float* out; unsigned char* ws; int ph_lo, ph_hi;
};

__device__ __forceinline__ void sincos_d(double x, double& s, double& c) {
    const double TWO_PI = 6.283185307179586476925286766559;
    x -= TWO_PI * rint(x / TWO_PI);
    const double q = x * 0.25, q2 = q * q;
    double sp = 1.0 / 6227020800.0; sp = sp * q2 - 1.0 / 39916800.0; sp = sp * q2 + 1.0 / 362880.0; sp = sp * q2 - 1.0 / 5040.0; sp = sp * q2 + 1.0 / 120.0; sp = sp * q2 - 1.0 / 6.0; sp = sp * q2 + 1.0; sp *= q;
    double cp = 1.0 / 87178291200.0; cp = cp * q2 - 1.0 / 479001600.0; cp = cp * q2 + 1.0 / 3628800.0; cp = cp * q2 - 1.0 / 40320.0; cp = cp * q2 + 1.0 / 720.0; cp = cp * q2 - 1.0 / 24.0; cp = cp * q2 + 0.5; cp = 1.0 - cp * q2;
    double s2 = 2.0 * sp * cp, c2 = 1.0 - 2.0 * sp * sp;
    s = 2.0 * s2 * c2; c = 1.0 - 2.0 * s2 * s2;
}

__device__ __forceinline__ void p0_prologue(Frame& F, const Ptrs& P) {
    unsigned char* ws = P.ws;
    LAS float* scr = (LAS float*)(F.lds + RING_OFF + F.wave * 16384);
    const int gw = F.vcu * NWAVES + F.wave, NGW = F.G * NWAVES;
    constexpr int I_INA = 32 * 128, I_OUTA = 16 * 64, I_INB = 32 * 144, I_OUTB = 32 * 64, I_INC = 32 * 64, I_GLU = 16 * 32, I_OUTC = 16 * 64;
    constexpr int NITEMS = 2 * I_INA + 2 * I_OUTA + I_INB + I_OUTB + I_INC + I_GLU + I_OUTC;
    for (int it = gw; it < NITEMS; it += NGW) {
        int r = it;
        if (r < I_INA) { p0_transpose_item(P.in[10], 2048, 4096, (bf16*)(ws + WS_WINA0), scr, r, F.lane); continue; } r -= I_INA;
        if (r < I_INA) { p0_transpose_item(P.in[10] + (size_t)2048 * 4096, 2048, 4096, (bf16*)(ws + WS_WINA1), scr, r, F.lane); continue; } r -= I_INA;
        if (r < I_OUTA) { p0_transpose_item(P.in[11], 1024, 2048, (bf16*)(ws + WS_WOUTA0), scr, r, F.lane); continue; } r -= I_OUTA;
        if (r < I_OUTA) { p0_transpose_item(P.in[11] + (size_t)1024 * 2048, 1024, 2048, (bf16*)(ws + WS_WOUTA1), scr, r, F.lane); continue; } r -= I_OUTA;
        if (r < I_INB) { p0_transpose_item(P.in[12], 2048, 4608, (bf16*)(ws + WS_WINB), scr, r, F.lane); continue; } r -= I_INB;
        if (r < I_OUTB) { p0_transpose_item(P.in[14], 2048, 2048, (bf16*)(ws + WS_WOUTB), scr, r, F.lane); continue; } r -= I_OUTB;
        if (r < I_INC) { p0_transpose_item(P.in[15], 2048, 2048, (bf16*)(ws + WS_WINC), scr, r, F.lane); continue; } r -= I_INC;
        if (r < I_GLU) { p0_transpose_item(P.in[24], 1024, 1024, (bf16*)(ws + WS_WGLU), scr, r, F.lane); continue; } r -= I_GLU;
        p0_transpose_item(P.in[25], 1024, 2048, (bf16*)(ws + WS_WOUTC), scr, r, F.lane);
    }
    bf16* XB = (bf16*)(ws + WS_XB);
    for (int m = gw; m < M; m += NGW) {
        const float* xr = (m < MP) ? P.in[0] + (size_t)m * DM : P.in[1] + (size_t)(m - MP) * DM;
#pragma unroll
        for (int j = 0; j < 4; ++j) { const int c = (j * 64 + F.lane) * 8; const f32x4 a = *(const GAS f32x4*)(xr + c), b = *(const GAS f32x4*)(xr + c + 4);
            v4u o; o.x = pk2(a.x, a.y); o.y = pk2(a.z, a.w); o.z = pk2(b.x, b.y); o.w = pk2(b.z, b.w); *(GAS v4u*)(XB + (size_t)m * DM + c) = o; }
    }
    const int gt = F.vcu * (NWAVES * 64) + F.tid;
    if (gt < 64 * 64) {
        const int g = gt >> 6, p = gt & 63;
        float* lam = (float*)(ws + WS_SSMC); float* lam64 = lam + 64 * 64 * 2; float* BB = lam64 + 64 * 64 * 2;
        const double are = fmin((double)P.in[16][gt], -1e-4), aim = (double)P.in[17][gt];
        const double dt = exp((double)P.in[18][g]);
        const double mag = exp(dt * are); double sn, cs; sincos_d(dt * aim, sn, cs);
        const double lr = mag * cs, li = mag * sn, nre = lr - 1.0, den = are * are + aim * aim;
        const double fre = (nre * are + li * aim) / den, fim = (li * are - nre * aim) / den;
        lam[2 * gt] = (float)lr; lam[2 * gt + 1] = (float)li;
        double pr = lr, pi = li;
#pragma unroll
        for (int i = 0; i < 6; ++i) { const double nr = pr * pr - pi * pi, ni = 2.0 * pr * pi; pr = nr; pi = ni; }
        lam64[2 * gt] = (float)pr; lam64[2 * gt + 1] = (float)pi;
        const float* bre = P.in[19] + (size_t)gt * 16; const float* bim = P.in[20] + (size_t)gt * 16;
#pragma unroll
        for (int c = 0; c < 16; ++c) { const double br = bre[c], bi = bim[c]; BB[(size_t)gt * 32 + c] = (float)(fre * br - fim * bi); BB[(size_t)gt * 32 + 16 + c] = (float)(fre * bi + fim * br); }
        (void)g; (void)p;
    }
}

namespace pg8 {
struct EpiProjA {
    static constexpr bool PERM = true, AFTER_DRAIN = false;
    bf16_t* O; float* kp; float* vp; float* ks; float* vs;
    __device__ __forceinline__ void operator()(const f32x4 (&acc)[2][2][4][2], const Unit& u, int wr, int wc, int fr, int fq) const {
        const int row0 = u.pm * BM + wr * 64 + fr, colt = u.pn * BM, col0 = colt + wc * 32 + 8 * fq;
        const int sect = u.pn >> 2;
        const float sc = (sect == 0) ? SB_SCALE : 1.0f;
        float* fbase = nullptr;
        if (sect == 1) fbase = (u.pm < NPM_P) ? kp + (size_t)row0 * 1024 : ks + (size_t)(row0 - MP) * 1024;
        if (sect == 2) fbase = (u.pm < NPM_P) ? vp + (size_t)row0 * 1024 : vs + (size_t)(row0 - MP) * 1024;
        const int fcol = col0 - sect * 1024;
#pragma unroll
        for (int ai = 0; ai < 2; ++ai)
#pragma unroll
            for (int m = 0; m < 4; ++m) { const int dr = ai * HALF + m * 16; bf16_t* rowp = O + (size_t)(row0 + dr) * 4096 + col0;
#pragma unroll
                for (int bj = 0; bj < 2; ++bj) { const f32x4 v0 = acc[ai][bj][m][0] * sc, v1 = acc[ai][bj][m][1] * sc;
                    u32x4 w; w.x = cvt_pk_bf16(v0[0], v0[1]); w.y = cvt_pk_bf16(v0[2], v0[3]); w.z = cvt_pk_bf16(v1[0], v1[1]); w.w = cvt_pk_bf16(v1[2], v1[3]);
                    *(u32x4*)(rowp + bj * HALF) = w;
                    if (fbase) { float* fp = fbase + (size_t)dr * 1024 + fcol + bj * HALF; *(f32x4*)fp = v0; *(f32x4*)(fp + 4) = v1; } } }
    }
};
struct EpiProjB {
    static constexpr bool PERM = true, AFTER_DRAIN = false;
    bf16_t* O; float* out;
    __device__ __forceinline__ void operator()(const f32x4 (&acc)[2][2][4][2], const Unit& u, int wr, int wc, int fr, int fq) const {
        const int row0 = u.pm * BM + wr * 64 + fr, colt = u.pn * BM, col0 = colt + wc * 32 + 8 * fq;
        const float sc = (u.pn < 8) ? 0.125f : 1.0f;
        const bool kv = (u.pn == 8 || u.pn == 9);
#pragma unroll
        for (int ai = 0; ai < 2; ++ai)
#pragma unroll
            for (int m = 0; m < 4; ++m) { const int row = row0 + ai * HALF + m * 16; bf16_t* rowp = O + (size_t)row * 4608 + col0;
                float* fp = nullptr;
                if (kv) {
                    if (row >= MP) fp = out + (u.pn == 8 ? O_KBS : O_VBS) + (size_t)(row - MP) * 256;
                    else { const int b = row / SEQ, t = row % SEQ; if (t >= SEQ - 128) fp = out + (u.pn == 8 ? O_KBP : O_VBP) + ((size_t)b * 128 + (t - (SEQ - 128))) * 256; }
                    if (fp) fp += (col0 - colt);
                }
#pragma unroll
                for (int bj = 0; bj < 2; ++bj) { const f32x4 v0 = acc[ai][bj][m][0] * sc, v1 = acc[ai][bj][m][1] * sc;
                    u32x4 w; w.x = cvt_pk_bf16(v0[0], v0[1]); w.y = cvt_pk_bf16(v0[2], v0[3]); w.z = cvt_pk_bf16(v1[0], v1[1]); w.w = cvt_pk_bf16(v1[2], v1[3]);
                    *(u32x4*)(rowp + bj * HALF) = w;
                    if (fp) { *(f32x4*)(fp + bj * HALF) = v0; *(f32x4*)(fp + bj * HALF + 4) = v1; } } }
    }
};
struct EpiResid {
    static constexpr bool PERM = false, AFTER_DRAIN = false;
    const float* xp; const float* xs; float* Z;
    __device__ __forceinline__ void operator()(const f32x4 (&acc)[2][2][4][2], const Unit& u, int wr, int wc, int fr, int fq) const {
        const int row0 = u.pm * BM + wr * 64 + fr, col0 = u.pn * BM + wc * 32 + 4 * fq;
        const float* xb = (u.pm < NPM_P) ? xp + (size_t)row0 * DM : xs + (size_t)(row0 - MP) * DM;
        float* zb = Z + (size_t)row0 * DM;
#pragma unroll
        for (int ai = 0; ai < 2; ++ai)
#pragma unroll
            for (int m = 0; m < 4; ++m) { const size_t off = (size_t)(ai * HALF + m * 16) * DM + col0;
#pragma unroll
                for (int bj = 0; bj < 2; ++bj)
#pragma unroll
                    for (int n = 0; n < 2; ++n) { const f32x4 xv = *(const f32x4*)(xb + off + bj * HALF + n * 16); *(f32x4*)(zb + off + bj * HALF + n * 16) = xv * ALPHA + acc[ai][bj][m][n]; } }
    }
};
struct EpiGlu {
    static constexpr bool PERM = true, AFTER_DRAIN = false;
    const bf16_t* Y1; const bf16_t* PROJ; bf16_t* O;
    __device__ __forceinline__ void operator()(const f32x4 (&acc)[2][2][4][2], const Unit& u, int wr, int wc, int fr, int fq) const {
        const int row0 = u.pm * BM + wr * 64 + fr, col0 = u.pn * BM + wc * 32 + 8 * fq;
#pragma unroll
        for (int ai = 0; ai < 2; ++ai)
#pragma unroll
            for (int m = 0; m < 4; ++m) { const size_t row = (size_t)(row0 + ai * HALF + m * 16);
#pragma unroll
                for (int bj = 0; bj < 2; ++bj) { const int c = col0 + bj * HALF;
                    const u32x4 yv = *(const u32x4*)(Y1 + row * 1024 + c), gv = *(const u32x4*)(PROJ + row * 2048 + 1024 + c);
                    float r[8];
#pragma unroll
                    for (int e = 0; e < 8; ++e) { const float a = (e < 4) ? acc[ai][bj][m][0][e] : acc[ai][bj][m][1][e - 4];
                        const unsigned yw = yv[e >> 1], gw = gv[e >> 1]; const float y = (e & 1) ? __uint_as_float(yw & 0xffff0000u) : __uint_as_float(yw << 16);
                        const float g = (e & 1) ? __uint_as_float(gw & 0xffff0000u) : __uint_as_float(gw << 16);
                        r[e] = y / (1.0f + __expf(-a)) * (g / (1.0f + __expf(-g))); }
                    u32x4 w; w.x = cvt_pk_bf16(r[0], r[1]); w.y = cvt_pk_bf16(r[2], r[3]); w.z = cvt_pk_bf16(r[4], r[5]); w.w = cvt_pk_bf16(r[6], r[7]);
                    *(u32x4*)(O + row * 1024 + c) = w; } }
    }
};
}

__device__ __forceinline__ void ln_phase(Frame& F, const float* Z, float* xf, bf16* XB, const float* g, const float* b) {
    const int gw = F.vcu * NWAVES + F.wave, NGW = F.G * NWAVES;
    for (int m = gw; m < M; m += NGW) {
        const GAS f32x4* zr = (const GAS f32x4*)(Z + (size_t)m * DM);
        f32x4 v[8]; float s = 0.f;
#pragma unroll
        for (int j = 0; j < 8; ++j) { v[j] = zr[(j >> 1) * 128 + F.lane * 2 + (j & 1)]; s += (v[j].x + v[j].y) + (v[j].z + v[j].w); }
        const float mean = wave_sum(s) * (1.f / DM); float s2 = 0.f;
#pragma unroll
        for (int j = 0; j < 8; ++j) { v[j] = v[j] - mean; s2 += (v[j].x * v[j].x + v[j].y * v[j].y) + (v[j].z * v[j].z + v[j].w * v[j].w); }
        const float rstd = 1.f / sqrtf(wave_sum(s2) * (1.f / DM) + LN_EPS);
        GAS f32x4* xr = (GAS f32x4*)(xf + (size_t)m * DM);
#pragma unroll
        for (int j = 0; j < 4; ++j) { const int c4 = j * 128 + F.lane * 2;
            const f32x4 g0 = *(const GAS f32x4*)(g + 4 * c4), g1 = *(const GAS f32x4*)(g + 4 * c4 + 4), b0 = *(const GAS f32x4*)(b + 4 * c4), b1 = *(const GAS f32x4*)(b + 4 * c4 + 4);
            const f32x4 o0 = v[2 * j] * rstd * g0 + b0, o1 = v[2 * j + 1] * rstd * g1 + b1;
            xr[c4] = o0; xr[c4 + 1] = o1;
            v4u o; o.x = pk2(o0.x, o0.y); o.y = pk2(o0.z, o0.w); o.z = pk2(o1.x, o1.y); o.w = pk2(o1.z, o1.w); *(GAS v4u*)(XB + (size_t)m * DM + 4 * c4) = o; }
    }
}

__device__ __forceinline__ void sb_attn_simple(Frame& F, const bf16* PROJ, const float* cache_k, const float* cache_v, bf16* AO) {
    LAS float* qs = (LAS float*)(F.lds + RING_OFF + F.wave * 1024);
    LAS float* wsm = qs + 128;
    const int lane = F.lane;
    const int gw = F.vcu * NWAVES + F.wave, NGW = F.G * NWAVES;
    for (int item = gw; item < M * 8; item += NGW) {
        const int m = item >> 3, h = item & 7;
        { const unsigned v = *(const GAS unsigned*)(PROJ + (size_t)m * 4096 + h * 128 + 2 * lane); qs[2 * lane] = bflo(v); qs[2 * lane + 1] = bfhi(v); }
        LDS_WAIT(); asm volatile("" ::: "memory");
        const bool sample = m >= MP;
        int b, qpos;
        if (!sample) { b = m / SEQ; qpos = m % SEQ; } else { b = (m - MP) >> 5; qpos = PAST + ((m - MP) & 31); }
        float later = 0.f, o0 = 0.f, o1 = 0.f;
        for (int e = qpos; e > 0; e -= 64) {
            const int pos = e - 64 + lane; const bool valid = pos >= 0;
            float z = 0.f;
            if (valid) {
                if (!sample || pos >= PAST) {
                    const size_t row = sample ? (size_t)(MP + b * 32 + (pos - PAST)) : (size_t)b * SEQ + pos;
                    const GAS v4u* kr = (const GAS v4u*)(PROJ + row * 4096 + 1024 + h * 128);
#pragma unroll 4
                    for (int c = 0; c < 16; ++c) { const v4u kv = kr[c]; const f32x4 qa = *(const LAS f32x4*)(qs + 8 * c), qb = *(const LAS f32x4*)(qs + 8 * c + 4);
                        z += bflo(kv.x) * qa.x + bfhi(kv.x) * qa.y + bflo(kv.y) * qa.z + bfhi(kv.y) * qa.w + bflo(kv.z) * qb.x + bfhi(kv.z) * qb.y + bflo(kv.w) * qb.z + bfhi(kv.w) * qb.w; }
                } else {
                    const GAS f32x4* kr = (const GAS f32x4*)(cache_k + (((size_t)b * PAST + pos) * 8 + h) * 128);
#pragma unroll 4
                    for (int c = 0; c < 32; ++c) { const f32x4 kv = kr[c]; const f32x4 qa = *(const LAS f32x4*)(qs + 4 * c); z += kv.x * qa.x + kv.y * qa.y + kv.z * qa.z + kv.w * qa.w; }
                }
            }
            const float l = valid ? -(fmaxf(z, 0.f) + __logf(1.0f + __expf(-fabsf(z)))) : 0.f;
            float s = l;
#pragma unroll
            for (int d = 1; d < 64; d <<= 1) { const float t = __shfl_down(s, d); if (lane + d < 64) s += t; }
            const float w = valid ? __expf(z + s + later) : 0.f;
            later += __shfl(s, 0);
            wsm[lane] = w;
            LDS_WAIT(); asm volatile("" ::: "memory");
            const int k0 = (e < 64) ? 64 - e : 0;
            for (int k = k0; k < 64; ++k) {
                const float wk = wsm[k]; const int p = e - 64 + k; unsigned vv;
                if (!sample || p >= PAST) { const size_t row = sample ? (size_t)(MP + b * 32 + (p - PAST)) : (size_t)b * SEQ + p; vv = *(const GAS unsigned*)(PROJ + row * 4096 + 2048 + h * 128 + 2 * lane); o0 += wk * bflo(vv); o1 += wk * bfhi(vv); }
                else { const f32x2v f = *(const GAS f32x2v*)(cache_v + (((size_t)b * PAST + p) * 8 + h) * 128 + 2 * lane); o0 += wk * f.x; o1 += wk * f.y; }
            }
            LDS_WAIT(); asm volatile("" ::: "memory");
            if (later < SB_CUT) break;
        }
        const unsigned gv = *(const GAS unsigned*)(PROJ + (size_t)m * 4096 + 3072 + h * 128 + 2 * lane);
        *(GAS unsigned*)(AO + (size_t)m * 1024 + h * 128 + 2 * lane) = pk2(o0 * silu_f(bflo(gv)), o1 * silu_f(bfhi(gv)));
    }
}

__device__ __forceinline__ void swa_attn_simple(Frame& F, const bf16* PROJ, const float* cache_k, const float* cache_v, const float* sinks, bf16* AO) {
    LAS float* qs = (LAS float*)(F.lds + RING_OFF + F.wave * 1024);
    LAS float* ps = qs + 64;
    const int lane = F.lane;
    const int gw = F.vcu * NWAVES + F.wave, NGW = F.G * NWAVES;
    for (int item = gw; item < M * 32; item += NGW) {
        const int m = item >> 5, hq = item & 31, kvh = hq >> 3;
        qs[lane] = __uint_as_float((unsigned)PROJ[(size_t)m * 4608 + hq * 64 + lane] << 16);
        LDS_WAIT(); asm volatile("" ::: "memory");
        const bool sample = m >= MP;
        const float slope = exp2f(-0.25f * (float)(hq + 1));
        const float sink = sinks[hq];
        int b, t, kstart, nk;
        if (!sample) { b = m / SEQ; t = m % SEQ; kstart = ((t >> 6) - 2) * 64; nk = 192; } else { b = (m - MP) >> 5; t = (m - MP) & 31; kstart = -128; nk = 160; }
        float lg[3];
#pragma unroll
        for (int i = 0; i < 3; ++i) {
            const int j = lane + 64 * i, pos = kstart + j; const bool valid = (j < nk) && (sample || pos >= 0);
            float z = -INFINITY;
            if (valid) {
                float d = 0.f;
                if (sample && pos < 0) { const GAS f32x4* kr = (const GAS f32x4*)(cache_k + (((size_t)b * 128 + j) * 4 + kvh) * 64);
#pragma unroll 4
                    for (int c = 0; c < 16; ++c) { const f32x4 kv = kr[c]; const f32x4 qa = *(const LAS f32x4*)(qs + 4 * c); d += kv.x * qa.x + kv.y * qa.y + kv.z * qa.z + kv.w * qa.w; } }
                else { const size_t row = sample ? (size_t)(MP + b * 32 + pos) : (size_t)b * SEQ + pos; const GAS v4u* kr = (const GAS v4u*)(PROJ + row * 4608 + 2048 + kvh * 64);
#pragma unroll 4
                    for (int c = 0; c < 8; ++c) { const v4u kv = kr[c]; const f32x4 qa = *(const LAS f32x4*)(qs + 8 * c), qb = *(const LAS f32x4*)(qs + 8 * c + 4);
                        d += bflo(kv.x) * qa.x + bfhi(kv.x) * qa.y + bflo(kv.y) * qa.z + bfhi(kv.y) * qa.w + bflo(kv.z) * qb.x + bfhi(kv.z) * qb.y + bflo(kv.w) * qb.z + bfhi(kv.w) * qb.w; } }
                const int dist = (t - pos) < 0 ? (pos - t) : (t - pos);
                z = d - slope * (float)dist;
            }
            lg[i] = z;
        }
        const float mx = fmaxf(wave_max(fmaxf(fmaxf(lg[0], lg[1]), lg[2])), sink);
        float e0 = __expf(lg[0] - mx), e1 = __expf(lg[1] - mx), e2 = __expf(lg[2] - mx);
        const float den = wave_sum(e0 + e1 + e2) + __expf(sink - mx);
        const float inv = 1.0f / den;
        ps[lane] = e0 * inv; ps[lane + 64] = e1 * inv; ps[lane + 128] = e2 * inv;
        LDS_WAIT(); asm volatile("" ::: "memory");
        float o = 0.f;
        const int j0 = (!sample && kstart < 0) ? -kstart : 0;
        for (int j = j0; j < nk; ++j) {
            const float pj = ps[j]; const int pos = kstart + j; float vv;
            if (sample && pos < 0) vv = cache_v[(((size_t)b * 128 + j) * 4 + kvh) * 64 + lane];
            else { const size_t row = sample ? (size_t)(MP + b * 32 + pos) : (size_t)b * SEQ + pos; vv = __uint_as_float((unsigned)PROJ[row * 4608 + 2304 + kvh * 64 + lane] << 16); }
            o += pj * vv;
        }
        LDS_WAIT(); asm volatile("" ::: "memory");
        const float g = __uint_as_float((unsigned)PROJ[(size_t)m * 4608 + 2560 + hq * 64 + lane] << 16);
        AO[(size_t)m * 2048 + hq * 64 + lane] = (bf16)f2bf(o * silu_f(g));
    }
}

__device__ __forceinline__ float tr_reduce16(const float (&v)[16], int lane) {
    float a[8], b[4], c[2];
    const bool b5 = lane & 32, b4 = lane & 16, b3 = lane & 8, b2 = lane & 4;
#pragma unroll
    for (int i = 0; i < 8; ++i) { const float send = b5 ? v[i] : v[i + 8], keep = b5 ? v[i + 8] : v[i]; a[i] = keep + __shfl_xor(send, 32); }
#pragma unroll
    for (int i = 0; i < 4; ++i) { const float send = b4 ? a[i] : a[i + 4], keep = b4 ? a[i + 4] : a[i]; b[i] = keep + __shfl_xor(send, 16); }
#pragma unroll
    for (int i = 0; i < 2; ++i) { const float send = b3 ? b[i] : b[i + 2], keep = b3 ? b[i + 2] : b[i]; c[i] = keep + __shfl_xor(send, 8); }
    const float send = b2 ? c[0] : c[1], keep = b2 ? c[1] : c[0];
    float d = keep + __shfl_xor(send, 4);
    d += __shfl_xor(d, 2); d += __shfl_xor(d, 1);
    return d;
}
template <bool FULL>
__device__ __forceinline__ void s5_block(Frame& F, const Ptrs& P, const bf16* PROJ, bf16* Y1, size_t row0, int T, int g, float& hr, float& hi) {
    LAS float* ub = (LAS float*)(F.lds + RING_OFF + F.wave * 8192);
    LAS float* yb = ub + 1024;
    const int lane = F.lane;
    const float* lam = (const float*)(P.ws + WS_SSMC); const float* BB = lam + 2 * 64 * 64 * 2;
    const int gp = g * 64 + lane;
    const float lr = lam[2 * gp], li = lam[2 * gp + 1];
    float br[16], bi[16];
#pragma unroll
    for (int c = 0; c < 4; ++c) { const f32x4 x = *(const GAS f32x4*)(BB + (size_t)gp * 32 + 4 * c), y = *(const GAS f32x4*)(BB + (size_t)gp * 32 + 16 + 4 * c);
        br[4 * c] = x.x; br[4 * c + 1] = x.y; br[4 * c + 2] = x.z; br[4 * c + 3] = x.w; bi[4 * c] = y.x; bi[4 * c + 1] = y.y; bi[4 * c + 2] = y.z; bi[4 * c + 3] = y.w; }
    float cr[16], ci[16];
    if (FULL) {
#pragma unroll
        for (int c = 0; c < 16; ++c) { cr[c] = P.in[21][(size_t)(g * 16 + c) * 64 + lane]; ci[c] = P.in[22][(size_t)(g * 16 + c) * 64 + lane]; }
    }
    if (lane < T) { const GAS v4u* ur = (const GAS v4u*)(PROJ + (row0 + lane) * 2048 + g * 16); const v4u a = ur[0], b = ur[1];
        LAS f32x4* d = (LAS f32x4*)(ub + lane * 16);
        d[0] = (f32x4){bflo(a.x), bfhi(a.x), bflo(a.y), bfhi(a.y)}; d[1] = (f32x4){bflo(a.z), bfhi(a.z), bflo(a.w), bfhi(a.w)};
        d[2] = (f32x4){bflo(b.x), bfhi(b.x), bflo(b.y), bfhi(b.y)}; d[3] = (f32x4){bflo(b.z), bfhi(b.z), bflo(b.w), bfhi(b.w)}; }
    LDS_WAIT(); asm volatile("" ::: "memory");
    for (int t = 0; t < T; ++t) {
        float u[16];
#pragma unroll
        for (int c = 0; c < 4; ++c) { const f32x4 x = *(const LAS f32x4*)(ub + t * 16 + 4 * c); u[4 * c] = x.x; u[4 * c + 1] = x.y; u[4 * c + 2] = x.z; u[4 * c + 3] = x.w; }
        float bur = 0.f, bui = 0.f;
#pragma unroll
        for (int c = 0; c < 16; ++c) { bur += u[c] * br[c]; bui += u[c] * bi[c]; }
        const float nr = lr * hr - li * hi + bur, ni = lr * hi + li * hr + bui;
        hr = nr; hi = ni;
        if (FULL) {
            float v[16];
#pragma unroll
            for (int c = 0; c < 16; ++c) v[c] = hr * cr[c] - hi * ci[c];
            const float y = tr_reduce16(v, lane);
            if ((lane & 3) == 0) yb[t * 16 + (((lane >> 5) & 1) * 8 + ((lane >> 4) & 1) * 4 + ((lane >> 3) & 1) * 2 + ((lane >> 2) & 1))] = y;
        }
    }
    if (FULL) {
        LDS_WAIT(); asm volatile("" ::: "memory");
        if (lane < T) {
            float r[16];
#pragma unroll
            for (int c = 0; c < 16; ++c) { const float y = yb[lane * 16 + c] + P.in[23][g * 16 + c] * ub[lane * 16 + c]; r[c] = gelu_tanh_f(y); }
            v4u a, b; a.x = pk2(r[0], r[1]); a.y = pk2(r[2], r[3]); a.z = pk2(r[4], r[5]); a.w = pk2(r[6], r[7]); b.x = pk2(r[8], r[9]); b.y = pk2(r[10], r[11]); b.z = pk2(r[12], r[13]); b.w = pk2(r[14], r[15]);
            GAS v4u* o = (GAS v4u*)(Y1 + (row0 + lane) * 1024 + g * 16); o[0] = a; o[1] = b;
        }
    }
    LDS_WAIT(); asm volatile("" ::: "memory");
}
__device__ __forceinline__ void s5_local(Frame& F, const Ptrs& P, const bf16* PROJ) {
    float* SEND = (float*)(P.ws + WS_SEND);
    for (int i = 0;; ++i) { const int item = (i * F.G + F.vcu) * NWAVES + F.wave; if (item >= 2 * 256 * 64) break;
        const int g = item & 63, bc = item >> 6;
        float hr = 0.f, hi = 0.f;
        s5_block<false>(F, P, PROJ, nullptr, (size_t)bc * 64, 64, g, hr, hi);
        SEND[((size_t)bc * 64 + g) * 128 + F.lane] = hr; SEND[((size_t)bc * 64 + g) * 128 + 64 + F.lane] = hi; }
}
__device__ __forceinline__ void s5_carry(Frame& F, const Ptrs& P) {
    const int gt = F.vcu * (NWAVES * 64) + F.tid;
    if (gt >= 2 * 64 * 64) return;
    const int b = gt >> 12, gp = gt & 4095, g = gp >> 6, p = gp & 63;
    const float* SEND = (const float*)(P.ws + WS_SEND); float* HIN = (float*)(P.ws + WS_HIN);
    const float* lam64 = (const float*)(P.ws + WS_SSMC) + 64 * 64 * 2;
    const float lr = lam64[2 * gp], li = lam64[2 * gp + 1];
    float hr = 0.f, hi = 0.f;
    for (int c0 = 0; c0 < 256; c0 += 8) {
        float sr[8], si[8];
#pragma unroll
        for (int k = 0; k < 8; ++k) { const size_t o = (((size_t)b * 256 + c0 + k) * 64 + g) * 128 + p; sr[k] = SEND[o]; si[k] = SEND[o + 64]; }
#pragma unroll
        for (int k = 0; k < 8; ++k) { const size_t o = (((size_t)b * 256 + c0 + k) * 64 + g) * 128 + p; HIN[o] = hr; HIN[o + 64] = hi;
            const float nr = lr * hr - li * hi + sr[k], ni = lr * hi + li * hr + si[k]; hr = nr; hi = ni; }
    }
    P.out[O_HRP + (size_t)b * 4096 + gp] = hr; P.out[O_HIP + (size_t)b * 4096 + gp] = hi;
}
__device__ __forceinline__ void s5_full(Frame& F, const Ptrs& P, const bf16* PROJ, bf16* Y1) {
    const float* HIN = (const float*)(P.ws + WS_HIN);
    constexpr int NP = 2 * 256 * 64, NS = 32 * 64;
    for (int i = 0;; ++i) { const int item = (i * F.G + F.vcu) * NWAVES + F.wave; if (item >= NP + NS) break;
        if (item < NP) { const int g = item & 63, bc = item >> 6;
            float hr = HIN[((size_t)bc * 64 + g) * 128 + F.lane], hi = HIN[((size_t)bc * 64 + g) * 128 + 64 + F.lane];
            s5_block<true>(F, P, PROJ, Y1, (size_t)bc * 64, 64, g, hr, hi);
        } else { const int it = item - NP, g = it & 63, b = it >> 6;
            float hr = P.in[6][((size_t)b * 64 + g) * 64 + F.lane], hi = P.in[7][((size_t)b * 64 + g) * 64 + F.lane];
            s5_block<true>(F, P, PROJ, Y1, (size_t)MP + b * 32, 32, g, hr, hi);
            P.out[O_HRS + ((size_t)b * 64 + g) * 64 + F.lane] = hr; P.out[O_HIS + ((size_t)b * 64 + g) * 64 + F.lane] = hi; }
    }
}

constexpr int N_PHASES = 20;
#ifndef MK_PER_PHASE
#define MK_PER_PHASE 0
#endif
#ifndef SP2
#define SP2 true
#endif
#ifndef ALIGNE
#define ALIGNE true
#endif
__global__ void __launch_bounds__(NWAVES * 64, 2) enc_fwd(Ptrs P) {
    extern __shared__ __attribute__((aligned(16))) unsigned char lds[];
    Frame F;
    F.lds = (LAS unsigned char*)lds;
    F.MISC = (volatile LAS unsigned*)(F.lds + MISC_OFF);
    F.tid = threadIdx.x; F.lane = F.tid & 63; F.wave = __builtin_amdgcn_readfirstlane(F.tid >> 6);
    F.G = gridDim.x; { const int bx = blockIdx.x; F.vcu = (F.G % 8 == 0) ? (bx % 8) * (F.G / 8) + bx / 8 : bx; }
    unsigned char* ws = P.ws;
    F.ctl = (gu32*)(ws + WS_CTL);
    for (int u = F.tid; u < (LDS_BYTES - LDSCTL_OFF) / 4; u += NWAVES * 64) ((LAS unsigned*)(F.lds + LDSCTL_OFF))[u] = 0u;
    __syncthreads();
    XcdBarrier bar; bar.bar = (unsigned*)(F.ctl + CW_BAR); bar.x = 0; bar.st = nullptr;
    if (!MK_PER_PHASE) bar = xcd_barrier_post((unsigned*)(F.ctl + CW_BAR), F.MISC + 8);
    const int lo = P.ph_lo, hi = P.ph_hi;
#define IN(k) (lo <= (k) && (k) < hi)
#define SEAM(k) do { if (IN(k) && IN((k) + 1)) xcd_barrier(bar); } while (0)
    bf16* const XB = (bf16*)(ws + WS_XB); float* const XF = (float*)(ws + WS_XF); bf16* const PROJ = (bf16*)(ws + WS_PROJ); bf16* const AO = (bf16*)(ws + WS_AO); bf16* const AOC = (bf16*)(ws + WS_AOC);
    const int bx = (int)blockIdx.x;

    if (IN(0)) { p0_prologue(F, P); } SEAM(0);
    if (IN(1)) { pg8::Gemm g{XB, (const bf16*)(ws + WS_WINA0), M, 4096, 2048}; pg8::StaticOrder S; S.init(M, 4096, F.G, bx);
        pg8::EpiProjA E{PROJ, P.out + O_KAP, P.out + O_VAP, P.out + O_KAS, P.out + O_VAS};
        pg8::gemm_phase<pg8::EpiProjA, pg8::StaticOrder, ALIGNE, SP2>(F.lds + RING_OFF, g, S, E); } SEAM(1);
    if (IN(2)) { sb_attn_simple(F, PROJ, P.in[2], P.in[3], AO); } SEAM(2);
    if (IN(3)) { pg8::Gemm g{AO, (const bf16*)(ws + WS_WOUTA0), M, 2048, 1024}; pg8::StaticOrder S; S.init(M, 2048, F.G, bx);
        pg8::EpiResid E{P.in[0], P.in[1], XF};
        pg8::gemm_phase<pg8::EpiResid, pg8::StaticOrder, ALIGNE, SP2>(F.lds + RING_OFF, g, S, E); } SEAM(3);
    if (IN(4)) { ln_phase(F, XF, XF, XB, P.in[8], P.in[9]); } SEAM(4);
    if (IN(5)) { pg8::Gemm g{XB, (const bf16*)(ws + WS_WINB), M, 4608, 2048}; pg8::StaticOrder S; S.init(M, 4608, F.G, bx);
        pg8::EpiProjB E{PROJ, P.out};
        pg8::gemm_phase<pg8::EpiProjB, pg8::StaticOrder, ALIGNE, SP2>(F.lds + RING_OFF, g, S, E); } SEAM(5);
    if (IN(6)) { swa_attn_simple(F, PROJ, P.in[4], P.in[5], P.in[13], AO); } SEAM(6);
    if (IN(7)) { pg8::Gemm g{AO, (const bf16*)(ws + WS_WOUTB), M, 2048, 2048}; pg8::StaticOrder S; S.init(M, 2048, F.G, bx);
        pg8::EpiResid E{XF, XF + (size_t)MP * DM, XF};
        pg8::gemm_phase<pg8::EpiResid, pg8::StaticOrder, ALIGNE, SP2>(F.lds + RING_OFF, g, S, E); } SEAM(7);
    if (IN(8)) { ln_phase(F, XF, XF, XB, P.in[8] + DM, P.in[9] + DM); } SEAM(8);
    if (IN(9)) { pg8::Gemm g{XB, (const bf16*)(ws + WS_WINC), M, 2048, 2048}; pg8::StaticOrder S; S.init(M, 2048, F.G, bx);
        pg8::EpiBf16<0> E{PROJ, 2048, nullptr, 0, 0, 1.f};
        pg8::gemm_phase<pg8::EpiBf16<0>, pg8::StaticOrder, ALIGNE, SP2>(F.lds + RING_OFF, g, S, E); } SEAM(9);
    if (IN(10)) { s5_local(F, P, PROJ); } SEAM(10);
    if (IN(11)) { s5_carry(F, P); } SEAM(11);
    if (IN(12)) { s5_full(F, P, PROJ, AO); } SEAM(12);
    if (IN(13)) { pg8::Gemm g{AO, (const bf16*)(ws + WS_WGLU), M, 1024, 1024}; pg8::StaticOrder S; S.init(M, 1024, F.G, bx);
        pg8::EpiGlu E{AO, PROJ, AOC};
        pg8::gemm_phase<pg8::EpiGlu, pg8::StaticOrder, ALIGNE, SP2>(F.lds + RING_OFF, g, S, E); } SEAM(13);
    if (IN(14)) { pg8::Gemm g{AOC, (const bf16*)(ws + WS_WOUTC), M, 2048, 1024}; pg8::StaticOrder S; S.init(M, 2048, F.G, bx);
        pg8::EpiResid E{XF, XF + (size_t)MP * DM, XF};
        pg8::gemm_phase<pg8::EpiResid, pg8::StaticOrder, ALIGNE, SP2>(F.lds + RING_OFF, g, S, E); } SEAM(14);
    if (IN(15)) { ln_phase(F, XF, XF, XB, P.in[8] + 2 * DM, P.in[9] + 2 * DM); } SEAM(15);
    if (IN(16)) { pg8::Gemm g{XB, (const bf16*)(ws + WS_WINA1), M, 4096, 2048}; pg8::StaticOrder S; S.init(M, 4096, F.G, bx);
        pg8::EpiProjA E{PROJ, P.out + O_KAP + (size_t)MP * 1024, P.out + O_VAP + (size_t)MP * 1024, P.out + O_KAS + (size_t)MS * 1024, P.out + O_VAS + (size_t)MS * 1024};
        pg8::gemm_phase<pg8::EpiProjA, pg8::StaticOrder, ALIGNE, SP2>(F.lds + RING_OFF, g, S, E); } SEAM(16);
    if (IN(17)) { sb_attn_simple(F, PROJ, P.in[2] + (size_t)DECB * PAST * 1024, P.in[3] + (size_t)DECB * PAST * 1024, AO); } SEAM(17);
    if (IN(18)) { pg8::Gemm g{AO, (const bf16*)(ws + WS_WOUTA1), M, 2048, 1024}; pg8::StaticOrder S; S.init(M, 2048, F.G, bx);
        pg8::EpiResid E{XF, XF + (size_t)MP * DM, XF};
        pg8::gemm_phase<pg8::EpiResid, pg8::StaticOrder, ALIGNE, SP2>(F.lds + RING_OFF, g, S, E); } SEAM(18);
    if (IN(19)) { ln_phase(F, XF, P.out + O_YP, XB, P.in[8] + 3 * DM, P.in[9] + 3 * DM); }
#undef IN
#undef SEAM
}

extern "C" void kernel_launch(void* const* d_in, const int* in_sizes, int n_in, void* d_out, int out_size, void* d_ws, size_t ws_size, hipStream_t stream) {
    static int grid = 0;
    if (grid == 0) {
        if (n_in != 26 || (size_t)out_size != O_END || ws_size < WS_END) { fprintf(stderr, "kernel_launch: unexpected shapes: n_in %d out %d (want %zu) ws %zu (want >= %zu); nothing launched\n", n_in, out_size, (size_t)O_END, ws_size, (size_t)WS_END); grid = -1; return; }
        int dev = 0, cus = 0, per_cu = 0;
        if (hipGetDevice(&dev) != hipSuccess || hipDeviceGetAttribute(&cus, hipDeviceAttributeMultiprocessorCount, dev) != hipSuccess) { fprintf(stderr, "kernel_launch: device query failed\n"); grid = -1; return; }
        if (hipFuncSetAttribute((const void*)enc_fwd, hipFuncAttributeMaxDynamicSharedMemorySize, LDS_BYTES) != hipSuccess) { fprintf(stderr, "kernel_launch: hipFuncSetAttribute failed\n"); grid = -1; return; }
        if (hipOccupancyMaxActiveBlocksPerMultiprocessor(&per_cu, (const void*)enc_fwd, NWAVES * 64, LDS_BYTES) != hipSuccess || per_cu < 1)
            fprintf(stderr, "kernel_launch: note: occupancy query reports %d workgroups per CU\n", per_cu);
        (void)hipGetLastError();
        grid = cus;
    }
    if (grid < 0) return;
    if (hipMemsetAsync((char*)d_ws + WS_CTL, 0, CTL_ZERO_BYTES, stream) != hipSuccess) { fprintf(stderr, "kernel_launch: memset failed\n"); return; }
    Ptrs a{};
    for (int i = 0; i < 26; ++i) a.in[i] = (const float*)d_in[i];
    a.out = (float*)d_out; a.ws = (unsigned char*)d_ws;
#if MK_PER_PHASE
    for (int ph = 0; ph < N_PHASES; ++ph) { a.ph_lo = ph; a.ph_hi = ph + 1; hipLaunchKernelGGL(enc_fwd, dim3(grid), dim3(NWAVES * 64), LDS_BYTES, stream, a); }
#else
    a.ph_lo = 0; a.ph_hi = N_PHASES;
    hipLaunchKernelGGL(enc_fwd, dim3(grid), dim3(NWAVES * 64), LDS_BYTES, stream, a);
#endif
    const hipError_t le = hipPeekAtLastError();
    if (le != hipSuccess) fprintf(stderr, "kernel_launch: launch failed: %s\n", hipGetErrorName(le));
}
```

```cpp
#include <hip/hip_runtime.h>
#include <cstdio>
#include <cstdint>
#ifndef PG8_WGM
#define PG8_WGM 6
#endif
namespace pg8 {
#define PG8_LAS __attribute__((address_space(3)))
typedef unsigned short bf16_t;
typedef short bf16x8 __attribute__((ext_vector_type(8)));
typedef float f32x4 __attribute__((ext_vector_type(4)));
typedef unsigned u32x4 __attribute__((ext_vector_type(4)));
constexpr int BM = 256, BK = 64, HALF = 128, HTB = HALF * BK * 2  , STAGE_BYTES = 8 * HTB, NXCD = 8, WGM = PG8_WGM;

__host__ __device__ __forceinline__ int lds_byte(int r, int c) { const int st = (r >> 4) * 2 + (c >> 5), rr = r & 15, cc = c & 31, ob = rr * 64 + cc * 2; return st * 1024 + (ob ^ (((ob >> 9) & 1) << 5)); }
__host__ __device__ __forceinline__ void stage_rc(int b, int& R, int& C) { const int st = b / 1024, sb = b % 1024, swz = sb ^ (((sb >> 9) & 1) << 5); R = (st >> 1) * 16 + swz / 64; C = (st & 1) * 32 + (swz % 64) / 2; }
__host__ __device__ __forceinline__ int perm32(int rho) { const int n = rho >> 4, i = rho & 15; return 8 * (i >> 2) + 4 * n + (i & 3); }

struct Unit { int pm, pn; };
struct Gemm { const bf16_t* A; const bf16_t* Bt; int M, N, K; };

struct StaticOrder {
    int nM, nN, nwg, G, c, pm0;
    __host__ __device__ void init(int M, int N, int G_, int c_) { nM = M / BM; nN = N / BM; nwg = nM * nN; G = G_; c = c_; pm0 = 0; }
    __host__ __device__ void init_part(int nMp, int pm0_, int N, int G_, int c_) { nM = nMp; nN = N / BM; nwg = nM * nN; G = G_; c = c_; pm0 = pm0_; }
    __host__ __device__ bool next(int i, Unit& u) const {
        const long L = (long)i * G + c; if (L >= nwg) return false;
        int wgid = (int)L; { const int q = nwg / NXCD, r = nwg % NXCD, xcd = wgid % NXCD, off = wgid / NXCD; wgid = (xcd < r ? xcd * (q + 1) : r * (q + 1) + (xcd - r) * q) + off; }
        const int nig = WGM * nN, gid = wgid / nig, fm = gid * WGM, gsz = (nM - fm) < WGM ? (nM - fm) : WGM;
        u.pm = pm0 + fm + ((wgid % nig) % gsz); u.pn = (wgid % nig) / gsz; return true;
    }
    __device__ __forceinline__ void a_ready(const Unit&) const {}
    __device__ __forceinline__ void done(const Unit&) const {}
};

__device__ __forceinline__ unsigned cvt_pk_bf16(float lo, float hi) { unsigned r; asm volatile("v_cvt_pk_bf16_f32 %0, %1, %2" : "=v"(r) : "v"(lo), "v"(hi)); return r; }
typedef float f32x2 __attribute__((ext_vector_type(2)));
__device__ __forceinline__ f32x2 gelu_pk(f32x2 v) {
    const f32x2 av = __builtin_elementwise_abs(v), d = av * 0.2316418882f + 1.0f;
    f32x2 t; t.x = __builtin_amdgcn_rcpf(d.x); t.y = __builtin_amdgcn_rcpf(d.y);
    f32x2 q = t * 0.5307027145f + (-0.7265760135f); q = q * t + 0.7107068705f; q = q * t + (-0.142248368f); q = q * t + 0.127414796f; q = q * t;
    const f32x2 s = (v * v) * (-0.72134752044f);
    f32x2 e; e.x = __builtin_amdgcn_exp2f(s.x); e.y = __builtin_amdgcn_exp2f(s.y);
    const f32x2 m = v * (q * e), r = v - m;
    f32x2 o; o.x = v.x < 0.f ? m.x : r.x; o.y = v.y < 0.f ? m.y : r.y; return o;
}

template <int ACT  > struct EpiBf16 {
    static constexpr bool PERM = true, AFTER_DRAIN = false; static_assert(ACT == 0 || ACT == 1, "EpiBf16: ACT is 0 (none) or 1 (gelu_pk)");
    bf16_t* O; int ldc; const float* bias; int split_cols; size_t split_stride; float scale0;
    __device__ __forceinline__ void operator()(const f32x4 (&acc)[2][2][4][2], const Unit& u, int wr, int wc, int fr, int fq) const {
        const int row0 = u.pm * BM + wr * 64 + fr; int colt = u.pn * BM; bf16_t* base = O;
        float sc = 1.f; if (split_cols) { const int t = colt / split_cols; base += (size_t)t * split_stride; colt -= t * split_cols; if (t == 0) sc = scale0; }
        const int col0 = colt + wc * 32 + 8 * fq, bcol0 = u.pn * BM + wc * 32 + 8 * fq;
        f32x4 bv[2][2];
#pragma unroll
        for (int bj = 0; bj < 2; ++bj)
#pragma unroll
            for (int n = 0; n < 2; ++n) bv[bj][n] = bias ? *(const f32x4*)(bias + bcol0 + bj * HALF + 4 * n) : (f32x4){0.f, 0.f, 0.f, 0.f};
#pragma unroll
        for (int ai = 0; ai < 2; ++ai)
#pragma unroll
            for (int m = 0; m < 4; ++m) { bf16_t* rowp = base + (size_t)(row0 + ai * HALF + m * 16) * ldc + col0;
#pragma unroll
                for (int bj = 0; bj < 2; ++bj) { f32x4 v0 = acc[ai][bj][m][0] + bv[bj][0], v1 = acc[ai][bj][m][1] + bv[bj][1];
                    if (ACT == 1) { f32x2 a = gelu_pk((f32x2){v0[0], v0[1]}), b = gelu_pk((f32x2){v0[2], v0[3]}), c = gelu_pk((f32x2){v1[0], v1[1]}), d = gelu_pk((f32x2){v1[2], v1[3]});
                        v0 = (f32x4){a.x, a.y, b.x, b.y}; v1 = (f32x4){c.x, c.y, d.x, d.y}; }
                    v0 = v0 * sc; v1 = v1 * sc; u32x4 w; w.x = cvt_pk_bf16(v0[0], v0[1]); w.y = cvt_pk_bf16(v0[2], v0[3]); w.z = cvt_pk_bf16(v1[0], v1[1]); w.w = cvt_pk_bf16(v1[2], v1[3]);
                    *(u32x4*)(rowp + bj * HALF) = w; } }
    }
};

template <class Epi, class Sched, bool ALIGN_EPI = false, bool SP2 = false>
__device__ __forceinline__ void gemm_phase(PG8_LAS unsigned char* lds, const Gemm g, const Sched& S, const Epi& E) {
    const int tid = threadIdx.x, wid = __builtin_amdgcn_readfirstlane(tid >> 6), lane = tid & 63, wr = wid >> 2, wc = wid & 3, fr = lane & 15, fq = lane >> 4;
    const int K = g.K, nt = K / BK;
    unsigned voffA[2], voffB[2];
#pragma unroll
    for (int i = 0; i < 2; ++i) { int R, C; stage_rc(tid * 16 + i * 8192, R, C); const int Rb = Epi::PERM ? ((R & ~31) + perm32(R & 31)) : R;
        voffA[i] = (unsigned)(R * K + C) * 2u; voffB[i] = (unsigned)(Rb * K + C) * 2u; }
    const size_t kstep = (size_t)(BK * 2);
    const size_t hstep = (size_t)HALF * K * 2;
    const size_t tstep = 2 * hstep;
    const unsigned ldsw = (unsigned)wid * 1024u;
    const int aoff = lds_byte(wr * 64 + fr, fq * 8), boff = lds_byte(wc * 32 + fr, fq * 8);
#define PG8_SA(b, h) (((b) * 2 + (h)) * HTB)
#define PG8_SB(b, h) ((4 + (b) * 2 + (h)) * HTB)
#define PG8_STAGE(bufoff, gbase, voff) do { _Pragma("unroll") for (int _i = 0; _i < 2; ++_i) \
        __builtin_amdgcn_global_load_lds((const unsigned*)((const char*)(gbase) + (voff)[_i]), (PG8_LAS unsigned*)(lds + (bufoff) + ldsw + _i * 8192), 16, 0, 0); } while (0)
#define PG8_LDA(dst, b, h) do { _Pragma("unroll") for (int m = 0; m < 4; ++m) _Pragma("unroll") for (int k = 0; k < 2; ++k) dst[m][k] = *(const PG8_LAS bf16x8*)(lds + PG8_SA(b, h) + aoff + m * 2048 + k * 1024); } while (0)
#define PG8_LDB(dst, b, h) do { _Pragma("unroll") for (int n = 0; n < 2; ++n) _Pragma("unroll") for (int k = 0; k < 2; ++k) dst[n][k] = *(const PG8_LAS bf16x8*)(lds + PG8_SB(b, h) + boff + n * 2048 + k * 1024); } while (0)
#define PG8_MMA(ai, bj, At, Bt) do { __builtin_amdgcn_s_setprio(1); _Pragma("unroll") for (int m = 0; m < 4; ++m) _Pragma("unroll") for (int n = 0; n < 2; ++n) _Pragma("unroll") for (int k = 0; k < 2; ++k) \
        acc[ai][bj][m][n] = __builtin_amdgcn_mfma_f32_16x16x32_bf16(Bt[n][k], At[m][k], acc[ai][bj][m][n], 0, 0, 0); __builtin_amdgcn_s_setprio(0); } while (0)
#define PG8_WAIT_V(n) asm volatile("s_waitcnt vmcnt(" #n ")" ::: "memory")
#define PG8_WAIT_L(n) asm volatile("s_waitcnt lgkmcnt(" #n ")" ::: "memory")
#define PG8_BAR __builtin_amdgcn_s_barrier()
#define PG8_SCHED __builtin_amdgcn_sched_barrier(0)
    Unit cur, nxt; int ui = 0;
    if (!S.next(0, cur)) return;
    f32x4 acc[2][2][4][2];
#pragma unroll
    for (int a = 0; a < 2; ++a)
#pragma unroll
        for (int b = 0; b < 2; ++b)
#pragma unroll
            for (int m = 0; m < 4; ++m)
#pragma unroll
                for (int n = 0; n < 2; ++n) acc[a][b][m][n] = (f32x4){0.f, 0.f, 0.f, 0.f};
    bf16x8 At[4][2], B0[2][2], B1[2][2];
    const char* cA = (const char*)g.A + (size_t)cur.pm * tstep; const char* cB = (const char*)g.Bt + (size_t)cur.pn * tstep;
    S.a_ready(cur);
    if constexpr (SP2) {
        PG8_STAGE(PG8_SB(0, 0), cB, voffB); PG8_STAGE(PG8_SB(0, 1), cB + hstep, voffB); PG8_STAGE(PG8_SA(0, 0), cA, voffA); PG8_STAGE(PG8_SA(0, 1), cA + hstep, voffA);
        if (wr == 1) PG8_BAR;
        PG8_WAIT_V(2); PG8_BAR;
        PG8_STAGE(PG8_SB(1, 0), cB + kstep, voffB); PG8_STAGE(PG8_SA(1, 0), cA + kstep, voffA); PG8_STAGE(PG8_SB(1, 1), cB + hstep + kstep, voffB);
        PG8_WAIT_V(6); PG8_BAR;
    } else {
        PG8_STAGE(PG8_SB(0, 0), cB, voffB); PG8_STAGE(PG8_SA(0, 0), cA, voffA); PG8_STAGE(PG8_SB(0, 1), cB + hstep, voffB); PG8_STAGE(PG8_SA(0, 1), cA + hstep, voffA);
        if (wr == 1) PG8_BAR;
        PG8_WAIT_V(4); PG8_BAR;
        PG8_STAGE(PG8_SB(1, 0), cB + kstep, voffB); PG8_STAGE(PG8_SA(1, 0), cA + kstep, voffA); PG8_STAGE(PG8_SB(1, 1), cB + hstep + kstep, voffB);
        PG8_WAIT_V(6); PG8_BAR;
    }
    for (;;) {
        const bool has_next = S.next(ui + 1, nxt);
        const char* nA = has_next ? (const char*)g.A + (size_t)nxt.pm * tstep : cA; const char* nB = has_next ? (const char*)g.Bt + (size_t)nxt.pn * tstep : cB;
        for (int t = 0; t < nt; t += 2) {
            const bool last = (t == nt - 2);
            const char* a1 = cA + (size_t)(t + 1) * kstep;
            const char* a2 = last ? nA : cA + (size_t)(t + 2) * kstep; const char* b2 = last ? nB : cB + (size_t)(t + 2) * kstep;
            const char* a3 = a2 + kstep; const char* b3 = b2 + kstep;
            if (last && has_next) S.a_ready(nxt);
            if constexpr (SP2) {
            PG8_LDB(B0, 0, 0); PG8_LDB(B1, 0, 1); PG8_SCHED; PG8_LDA(At, 0, 0); PG8_STAGE(PG8_SA(1, 1), a1 + hstep, voffA);
            PG8_WAIT_V(8); PG8_WAIT_L(0); PG8_BAR; PG8_MMA(0, 0, At, B0); PG8_MMA(0, 1, At, B1); PG8_BAR; PG8_SCHED;
            PG8_LDA(At, 0, 1); PG8_STAGE(PG8_SB(0, 0), b2, voffB); PG8_STAGE(PG8_SB(0, 1), b2 + hstep, voffB); PG8_STAGE(PG8_SA(0, 0), a2, voffA);
            PG8_WAIT_V(8); PG8_WAIT_L(0); PG8_BAR; PG8_MMA(1, 0, At, B0); PG8_MMA(1, 1, At, B1); PG8_BAR; PG8_SCHED;
            PG8_LDB(B0, 1, 0); PG8_LDB(B1, 1, 1); PG8_SCHED; PG8_LDA(At, 1, 0); PG8_STAGE(PG8_SA(0, 1), a2 + hstep, voffA);
            PG8_WAIT_V(8); PG8_WAIT_L(0); PG8_BAR; PG8_MMA(0, 0, At, B0); PG8_MMA(0, 1, At, B1); PG8_BAR; PG8_SCHED;
            PG8_LDA(At, 1, 1); PG8_STAGE(PG8_SB(1, 0), b3, voffB); PG8_STAGE(PG8_SB(1, 1), b3 + hstep, voffB); PG8_STAGE(PG8_SA(1, 0), a3, voffA);
            PG8_WAIT_V(8); PG8_WAIT_L(0); PG8_BAR; PG8_MMA(1, 0, At, B0); PG8_MMA(1, 1, At, B1); PG8_BAR; PG8_SCHED;
            } else {
            PG8_LDB(B0, 0, 0); PG8_SCHED; PG8_LDA(At, 0, 0); PG8_STAGE(PG8_SA(1, 1), a1 + hstep, voffA);
            PG8_WAIT_L(8); PG8_BAR; PG8_WAIT_L(0); PG8_MMA(0, 0, At, B0); PG8_BAR; PG8_SCHED;
            PG8_LDB(B1, 0, 1); PG8_STAGE(PG8_SB(0, 0), b2, voffB);
            PG8_BAR; PG8_WAIT_L(0); PG8_MMA(0, 1, At, B1); PG8_BAR;
            PG8_LDA(At, 0, 1); PG8_STAGE(PG8_SA(0, 0), a2, voffA);
            PG8_BAR; PG8_WAIT_L(0); PG8_MMA(1, 0, At, B0); PG8_BAR; PG8_SCHED;
            PG8_STAGE(PG8_SB(0, 1), b2 + hstep, voffB);
            PG8_WAIT_V(6); PG8_BAR; PG8_MMA(1, 1, At, B1); PG8_BAR;
            PG8_LDB(B0, 1, 0); PG8_SCHED; PG8_LDA(At, 1, 0); PG8_STAGE(PG8_SA(0, 1), a2 + hstep, voffA);
            PG8_WAIT_L(8); PG8_BAR; PG8_WAIT_L(0); PG8_MMA(0, 0, At, B0); PG8_BAR; PG8_SCHED;
            PG8_LDB(B1, 1, 1); PG8_STAGE(PG8_SB(1, 0), b3, voffB);
            PG8_BAR; PG8_WAIT_L(0); PG8_MMA(0, 1, At, B1); PG8_BAR;
            PG8_LDA(At, 1, 1); PG8_STAGE(PG8_SA(1, 0), a3, voffA);
            PG8_BAR; PG8_WAIT_L(0); PG8_MMA(1, 0, At, B0); PG8_BAR; PG8_SCHED;
            PG8_STAGE(PG8_SB(1, 1), b3 + hstep, voffB);
            PG8_WAIT_V(6); PG8_BAR; PG8_MMA(1, 1, At, B1); PG8_BAR;
            }
        }
        if constexpr (ALIGN_EPI) { if (wr == 0) PG8_BAR; }
        if constexpr (!Epi::AFTER_DRAIN) { E(acc, cur, wr, wc, fr, fq); S.done(cur); }
        if (!has_next) break;
#pragma unroll
        for (int a = 0; a < 2; ++a)
#pragma unroll
            for (int b = 0; b < 2; ++b)
#pragma unroll
                for (int m = 0; m < 4; ++m)
#pragma unroll
                    for (int n = 0; n < 2; ++n) acc[a][b][m][n] = (f32x4){0.f, 0.f, 0.f, 0.f};
        cur = nxt; cA = nA; cB = nB; ++ui;
        if constexpr (ALIGN_EPI) { if (wr == 1) PG8_BAR; }
    }
    PG8_WAIT_V(0);
    if constexpr (!ALIGN_EPI) { if (wr == 0) PG8_BAR; }
    PG8_BAR;
    if constexpr (Epi::AFTER_DRAIN) { E.fused(acc, cur, wr, wc, fr, fq, lds, wid, lane); S.done(cur); }
#undef PG8_SA
#undef PG8_SB
#undef PG8_STAGE
#undef PG8_LDA
#undef PG8_LDB
#undef PG8_MMA
#undef PG8_WAIT_V
#undef PG8_WAIT_L
#undef PG8_BAR
#undef PG8_SCHED
}
}
#define GAS __attribute__((address_space(1)))
#define LAS __attribute__((address_space(3)))
typedef unsigned short bf16;
typedef unsigned v4u __attribute__((ext_vector_type(4)));
typedef float f32x4 __attribute__((ext_vector_type(4)));
typedef short bf16x8 __attribute__((ext_vector_type(8)));
typedef GAS unsigned gu32;
typedef GAS unsigned long long gu64;
#define RLX_AGENT __ATOMIC_RELAXED, __HIP_MEMORY_SCOPE_AGENT
#define LDS_WAIT() asm volatile("s_waitcnt lgkmcnt(0)" ::: "memory")
#define VM_WAIT() asm volatile("s_waitcnt vmcnt(0)" ::: "memory")
__device__ __forceinline__ unsigned long long rt() { return __builtin_amdgcn_s_memrealtime(); }
__device__ __forceinline__ unsigned f2bf(float f) { unsigned u = __builtin_bit_cast(unsigned, f); return (u + 0x7fffu + ((u >> 16) & 1u)) >> 16; }
__device__ __forceinline__ unsigned pk2(float lo, float hi) { return f2bf(lo) | (f2bf(hi) << 16); }

#define XB_TMO      128
#define XB_XCNT(j)  (256  + 64 * (j))
#define XB_XSUB(j)  (1280 + 64 * (j))
#define XB_XGEN(j)  (2304 + 64 * (j))
#define XB_TOP      3328
#define XB_TOPGEN   3392
#define XCD_BAR_WORDS 3456
#define XB_SPIN_CAP (1u << 18)

__device__ __forceinline__ unsigned xb_ld(unsigned* p)              { return __hip_atomic_load(p, __ATOMIC_RELAXED, __HIP_MEMORY_SCOPE_AGENT); }
__device__ __forceinline__ unsigned xb_add(unsigned* p, unsigned v) { return __hip_atomic_fetch_add(p, v, __ATOMIC_RELAXED, __HIP_MEMORY_SCOPE_AGENT); }
__device__ __forceinline__ unsigned xb_xcc_id() { return (unsigned)__builtin_amdgcn_s_getreg((3 << 11) | 20) & 0xFu; }
#define XB_SPIN(cond, bar) do { unsigned _sp = 0; while (cond) { __builtin_amdgcn_s_sleep(1); \
    if ((++_sp & 255u) == 0u) { if (xb_ld(&(bar)[XB_TMO])) break; if (_sp > XB_SPIN_CAP) { atomicAdd(&(bar)[XB_TMO], 1u); break; } } } } while (0)

struct XcdBarrier {
    unsigned* bar; unsigned x;
    volatile LAS unsigned* st;
};

__device__ __forceinline__ XcdBarrier xcd_barrier_post(unsigned* bar, volatile LAS unsigned* st) {
    XcdBarrier b; b.bar = bar; b.x = xb_xcc_id(); b.st = st;
    if (threadIdx.x == 0) (void)xb_add(&bar[XB_XCNT(b.x)], 1u);
    return b;
}
__device__ __forceinline__ void xcd_barrier_complete(unsigned* bar, unsigned x, unsigned& nloc, unsigned& nx) {
    const unsigned G = gridDim.x * gridDim.y * gridDim.z;
    unsigned sum, cnt, mine, sp = 0u;
    for (;;) {
        sum = 0u; cnt = 0u; mine = 0u;
#pragma unroll
        for (unsigned j = 0; j < 16; ++j) { const unsigned c = xb_ld(&bar[XB_XCNT(j)]); sum += c; cnt += (c > 0u) ? 1u : 0u; mine = (j == x) ? c : mine; }
        if (sum == G) break;
        __builtin_amdgcn_s_sleep(1);
        if ((++sp & 255u) == 0u) { if (xb_ld(&bar[XB_TMO])) break; if (sp > XB_SPIN_CAP) { atomicAdd(&bar[XB_TMO], 1u); break; } }
    }
    nloc = mine > 0u ? mine : 1u; nx = cnt > 0u ? cnt : 1u;
}

__device__ __forceinline__ void xcd_barrier(const XcdBarrier& b) {
    asm volatile("s_waitcnt vmcnt(0)" ::: "memory");
    __syncthreads();
    if (threadIdx.x == 0) {
        unsigned* bar = b.bar;
        __builtin_amdgcn_s_waitcnt(0);
        unsigned nloc = b.st[0], nx = b.st[1];
        if (nloc == 0u) { xcd_barrier_complete(bar, b.x, nloc, nx); b.st[0] = nloc; b.st[1] = nx; }
        const unsigned old = xb_add(&bar[XB_XSUB(b.x)], 1u);
        const unsigned gen = old / nloc;
        if (old + 1u == (gen + 1u) * nloc) {
            __builtin_amdgcn_fence(__ATOMIC_RELEASE, "agent");
            asm volatile("s_waitcnt vmcnt(0)" ::: "memory");
            const unsigned og = xb_add(&bar[XB_TOP], 1u);
            const unsigned tg = og / nx;
            if (og + 1u == (tg + 1u) * nx) xb_add(&bar[XB_TOPGEN], 1u);
            else XB_SPIN(xb_ld(&bar[XB_TOPGEN]) == tg, bar);
            __builtin_amdgcn_fence(__ATOMIC_ACQUIRE, "agent");
            xb_add(&bar[XB_XGEN(b.x)], 1u);
            asm volatile("s_waitcnt vmcnt(0)" ::: "memory");
        } else {
            XB_SPIN(xb_ld(&bar[XB_XGEN(b.x)]) == gen, bar);
            __builtin_amdgcn_fence(__ATOMIC_ACQUIRE, "agent");
            asm volatile("s_waitcnt vmcnt(0)" ::: "memory");
        }
    }
    __syncthreads();
}

constexpr int NWAVES = 8;
constexpr int DM = 2048, SEQ = 16384, NBATCH = 2, MP = NBATCH * SEQ, DECB = 32, DECS = 32, MS = DECB * DECS, M = MP + MS, PAST = 2048;
constexpr int NPM = M / 256, NPM_P = MP / 256;
constexpr float ALPHA = 1.6817928305074290f;
constexpr float LN_EPS = 1e-5f;
constexpr float SB_SCALE = 0.08838834764831845f;
#ifndef SB_CUT_VAL
#define SB_CUT_VAL -104.0f
#endif
constexpr float SB_CUT = SB_CUT_VAL;
constexpr float SB_QSCALE = SB_SCALE * 1.4426950408889634f;
constexpr float SB_CUT2 = SB_CUT * 1.4426950408889634f - 0.1f;
constexpr size_t O_YP = 0, O_YS = O_YP + (size_t)MP * DM, O_KAP = O_YS + (size_t)MS * DM, O_VAP = O_KAP + 2ull * MP * 1024, O_KAS = O_VAP + 2ull * MP * 1024,
    O_VAS = O_KAS + 2ull * MS * 1024, O_KBP = O_VAS + 2ull * MS * 1024, O_VBP = O_KBP + 2ull * 128 * 256, O_KBS = O_VBP + 2ull * 128 * 256, O_VBS = O_KBS + (size_t)MS * 256,
    O_HRP = O_VBS + (size_t)MS * 256, O_HIP = O_HRP + 2 * 64 * 64, O_HRS = O_HIP + 2 * 64 * 64, O_HIS = O_HRS + 32 * 64 * 64, O_END = O_HIS + 32 * 64 * 64;
constexpr size_t MiB = 1u << 20;
constexpr size_t WS_CTL = 0, CTL_ZERO_BYTES = 2 * MiB;
constexpr size_t WS_C1C2 = 65536, WS_STATS = 262144;
constexpr size_t WS_SSMC = 86 * MiB;
constexpr size_t WS_WINA0 = 2 * MiB, WS_WINA1 = 18 * MiB, WS_WOUTA0 = 34 * MiB, WS_WOUTA1 = 38 * MiB, WS_WINB = 42 * MiB, WS_WOUTB = 60 * MiB, WS_WINC = 68 * MiB, WS_WGLU = 76 * MiB, WS_WOUTC = 78 * MiB;
constexpr size_t WS_BBB = 84 * MiB, WS_CMB = 85 * MiB;
constexpr size_t WS_XB = 96 * MiB;
constexpr size_t WS_XF = 256 * MiB;
constexpr size_t WS_PROJ = 520 * MiB;
constexpr size_t WS_AO = 832 * MiB;
constexpr size_t WS_AOC = 900 * MiB;
constexpr size_t WS_SEND = 968 * MiB, WS_HIN = 984 * MiB, WS_END = 1000 * MiB;
constexpr int CW_TMO = 0, CW_CODE = 1, CW_BAR = 4096;
constexpr int RING_OFF = 0, RING_BYTES = 131072, LDSCTL_OFF = RING_BYTES, MISC_OFF = LDSCTL_OFF + 320, LDS_BYTES = 147456;

struct Frame {
    LAS unsigned char* lds;
    volatile LAS unsigned* MISC;
    gu32* ctl;
    int tid, lane, wave;
    int vcu, G;
};
typedef float f32x2v __attribute__((ext_vector_type(2)));
__device__ __forceinline__ float bflo(unsigned v) { return __uint_as_float(v << 16); }
__device__ __forceinline__ float bfhi(unsigned v) { return __uint_as_float(v & 0xffff0000u); }
__device__ __forceinline__ float wave_sum(float v) {
#pragma unroll
    for (int o = 1; o < 64; o <<= 1) v += __shfl_xor(v, o);
    return v;
}
__device__ __forceinline__ float wave_max(float v) {
#pragma unroll
    for (int o = 1; o < 64; o <<= 1) v = fmaxf(v, __shfl_xor(v, o));
    return v;
}
__device__ __forceinline__ float silu_f(float g) { return g / (1.0f + __expf(-g)); }
__device__ __forceinline__ float gelu_tanh_f(float x) { const float a = 0.7978845608028654f * (x + 0.044715f * x * x * x); const float e = __expf(2.0f * a); return 0.5f * x * (2.0f - 2.0f / (1.0f + e)); }

__device__ __forceinline__ void p0_transpose_item(const float* W, int K, int N, bf16* WT, LAS float* scr, int item, int lane, const float* g, const float* b, float* c1, float* c2) {
    const int nblk = N / 32, kb = item / nblk, nb = item % nblk, k0 = 64 * kb, n0 = 32 * nb;
    { float wv[32];
#pragma unroll
      for (int i = 0; i < 32; ++i) wv[i] = W[(size_t)(k0 + 2 * i + (lane >> 5)) * N + n0 + (lane & 31)];
#pragma unroll
      for (int i = 0; i < 32; ++i) scr[(2 * i + (lane >> 5)) * 33 + (lane & 31)] = wv[i]; }
    LDS_WAIT(); asm volatile("" ::: "memory");
    const int c = lane & 7;
    f32x4 g0 = {1.f, 1.f, 1.f, 1.f}, g1 = g0, b0 = {0.f, 0.f, 0.f, 0.f}, b1 = b0;
    if (g) { g0 = *(const GAS f32x4*)(g + k0 + 8 * c); g1 = *(const GAS f32x4*)(g + k0 + 8 * c + 4); b0 = *(const GAS f32x4*)(b + k0 + 8 * c); b1 = *(const GAS f32x4*)(b + k0 + 8 * c + 4); }
#pragma unroll
    for (int j = 0; j < 4; ++j) { const int n = (lane >> 3) + 8 * j; const LAS float* s = scr + (8 * c) * 33 + n;
        const float w0 = s[0 * 33], w1 = s[1 * 33], w2 = s[2 * 33], w3 = s[3 * 33], w4 = s[4 * 33], w5 = s[5 * 33], w6 = s[6 * 33], w7 = s[7 * 33];
        v4u o; o.x = pk2(w0 * g0.x, w1 * g0.y); o.y = pk2(w2 * g0.z, w3 * g0.w); o.z = pk2(w4 * g1.x, w5 * g1.y); o.w = pk2(w6 * g1.z, w7 * g1.w);
        *(GAS v4u*)(WT + (size_t)(n0 + n) * K + k0 + 8 * c) = o;
        if (g) {
            float s1 = ((bflo(o.x) + bfhi(o.x)) + (bflo(o.y) + bfhi(o.y))) + ((bflo(o.z) + bfhi(o.z)) + (bflo(o.w) + bfhi(o.w)));
            float s2 = ((w0 * b0.x + w1 * b0.y) + (w2 * b0.z + w3 * b0.w)) + ((w4 * b1.x + w5 * b1.y) + (w6 * b1.z + w7 * b1.w));
            s1 += __shfl_xor(s1, 1); s2 += __shfl_xor(s2, 1); s1 += __shfl_xor(s1, 2); s2 += __shfl_xor(s2, 2); s1 += __shfl_xor(s1, 4); s2 += __shfl_xor(s2, 4);
            if (c == 0) { const float o1 = unsafeAtomicAdd(c1 + n0 + n, s1), o2 = unsafeAtomicAdd(c2 + n0 + n, s2); asm volatile("" :: "v"(o1), "v"(o2)); }
        } }
    LDS_WAIT(); asm volatile("" ::: "memory");
}

struct Ptrs {
    const float* in[26]; float* out; unsigned char* ws; int ph_lo, ph_hi;
};

__device__ __forceinline__ void sincos_d(double x, double& s, double& c) {
    const double TWO_PI = 6.283185307179586476925286766559;
    x -= TWO_PI * rint(x / TWO_PI);
    const double q = x * 0.25, q2 = q * q;
    double sp = 1.0 / 6227020800.0; sp = sp * q2 - 1.0 / 39916800.0; sp = sp * q2 + 1.0 / 362880.0; sp = sp * q2 - 1.0 / 5040.0; sp = sp * q2 + 1.0 / 120.0; sp = sp * q2 - 1.0 / 6.0; sp = sp * q2 + 1.0; sp *= q;
    double cp = 1.0 / 87178291200.0; cp = cp * q2 - 1.0 / 479001600.0; cp = cp * q2 + 1.0 / 3628800.0; cp = cp * q2 - 1.0 / 40320.0; cp = cp * q2 + 1.0 / 720.0; cp = cp * q2 - 1.0 / 24.0; cp = cp * q2 + 0.5; cp = 1.0 - cp * q2;
    double s2 = 2.0 * sp * cp, c2 = 1.0 - 2.0 * sp * sp;
    s = 2.0 * s2 * c2; c = 1.0 - 2.0 * s2 * s2;
}

constexpr int PW_R0 = 32 * 128, PW_R1 = PW_R0 + 16 * 64 + 32 * 144 + 32 * 64, PW_R2 = PW_R1 + 32 * 64 + 16 * 32 + 16 * 64 + 32 * 128 + 16 * 64;
__device__ __forceinline__ void p0_weights(Frame& F, const Ptrs& P, int lo, int hi, int vw, int nvw) {
    unsigned char* ws = P.ws;
    LAS float* scr = (LAS float*)(F.lds + RING_OFF + F.wave * 16384);
    float* const C1C2 = (float*)(ws + WS_C1C2);
    constexpr int I_INA = 32 * 128, I_OUTA = 16 * 64, I_INB = 32 * 144, I_OUTB = 32 * 64, I_INC = 32 * 64, I_GLU = 16 * 32, I_OUTC = 16 * 64;
    for (int it = lo + vw; it < hi; it += nvw) {
        int r = it;
        if (r < I_INA) { p0_transpose_item(P.in[10], 2048, 4096, (bf16*)(ws + WS_WINA0), scr, r, F.lane, nullptr, nullptr, nullptr, nullptr); continue; } r -= I_INA;
        if (r < I_OUTA) { p0_transpose_item(P.in[11], 1024, 2048, (bf16*)(ws + WS_WOUTA0), scr, r, F.lane, nullptr, nullptr, nullptr, nullptr); continue; } r -= I_OUTA;
        if (r < I_INB) { p0_transpose_item(P.in[12], 2048, 4608, (bf16*)(ws + WS_WINB), scr, r, F.lane, P.in[8], P.in[9], C1C2, C1C2 + 4608); continue; } r -= I_INB;
        if (r < I_OUTB) { p0_transpose_item(P.in[14], 2048, 2048, (bf16*)(ws + WS_WOUTB), scr, r, F.lane, nullptr, nullptr, nullptr, nullptr); continue; } r -= I_OUTB;
        if (r < I_INC) { p0_transpose_item(P.in[15], 2048, 2048, (bf16*)(ws + WS_WINC), scr, r, F.lane, P.in[8] + DM, P.in[9] + DM, C1C2 + 2 * 4608, C1C2 + 3 * 4608); continue; } r -= I_INC;
        if (r < I_GLU) { p0_transpose_item(P.in[24], 1024, 1024, (bf16*)(ws + WS_WGLU), scr, r, F.lane, nullptr, nullptr, nullptr, nullptr); continue; } r -= I_GLU;
        if (r < I_OUTC) { p0_transpose_item(P.in[25], 1024, 2048, (bf16*)(ws + WS_WOUTC), scr, r, F.lane, nullptr, nullptr, nullptr, nullptr); continue; } r -= I_OUTC;
        if (r < I_INA) { p0_transpose_item(P.in[10] + (size_t)2048 * 4096, 2048, 4096, (bf16*)(ws + WS_WINA1), scr, r, F.lane, P.in[8] + 2 * DM, P.in[9] + 2 * DM, C1C2 + 4 * 4608, C1C2 + 5 * 4608); continue; } r -= I_INA;
        p0_transpose_item(P.in[11] + (size_t)1024 * 2048, 1024, 2048, (bf16*)(ws + WS_WOUTA1), scr, r, F.lane, nullptr, nullptr, nullptr, nullptr);
    }
}
__device__ __forceinline__ void p0_prologue(Frame& F, const Ptrs& P) {
    unsigned char* ws = P.ws;
    const int gw = F.vcu * NWAVES + F.wave, NGW = F.G * NWAVES;
    p0_weights(F, P, 0, PW_R0, gw, NGW);
    bf16* XB = (bf16*)(ws + WS_XB);
    for (int m0 = 2 * gw; m0 < M; m0 += 2 * NGW) {
        f32x4 xa[2][4], xb[2][4];
#pragma unroll
        for (int r = 0; r < 2; ++r) { const int m = m0 + r; const float* xr = (m < MP) ? P.in[0] + (size_t)m * DM : P.in[1] + (size_t)(m - MP) * DM;
#pragma unroll
            for (int j = 0; j < 4; ++j) { const int c = (j * 64 + F.lane) * 8; xa[r][j] = *(const GAS f32x4*)(xr + c); xb[r][j] = *(const GAS f32x4*)(xr + c + 4); } }
        asm volatile("" ::: "memory");
#pragma unroll
        for (int r = 0; r < 2; ++r)
#pragma unroll
            for (int j = 0; j < 4; ++j) { const int c = (j * 64 + F.lane) * 8; const f32x4 a = xa[r][j], b = xb[r][j];
                v4u o; o.x = pk2(a.x, a.y); o.y = pk2(a.z, a.w); o.z = pk2(b.x, b.y); o.w = pk2(b.z, b.w); *(GAS v4u*)(XB + (size_t)(m0 + r) * DM + c) = o; }
    }
}
__device__ __forceinline__ void p0_s5tables(const Ptrs& P, int gt0, int gstride) {
    unsigned char* ws = P.ws;
    for (int gt = gt0; gt < 64 * 64; gt += gstride) {
        const int g = gt >> 6, p = gt & 63;
        float* lam = (float*)(ws + WS_SSMC); float* lam64 = lam + 64 * 64 * 2; float* BB = lam64 + 64 * 64 * 2;
        const double are = fmin((double)P.in[16][gt], -1e-4), aim = (double)P.in[17][gt];
        const double dt = exp((double)P.in[18][g]);
        const double mag = exp(dt * are); double sn, cs; sincos_d(dt * aim, sn, cs);
        const double lr = mag * cs, li = mag * sn, nre = lr - 1.0, den = are * are + aim * aim;
        const double fre = (nre * are + li * aim) / den, fim = (li * are - nre * aim) / den;
        double pr = lr, pi = li;
#pragma unroll
        for (int i = 0; i < 6; ++i) { const double nr = pr * pr - pi * pi, ni = 2.0 * pr * pi; pr = nr; pi = ni; }
        f32x4 brv[4], biv[4]; float cre[16], cim[16];
#pragma unroll
        for (int c = 0; c < 4; ++c) { brv[c] = *(const GAS f32x4*)(P.in[19] + (size_t)gt * 16 + 4 * c); biv[c] = *(const GAS f32x4*)(P.in[20] + (size_t)gt * 16 + 4 * c); }
#pragma unroll
        for (int c = 0; c < 16; ++c) { cre[c] = P.in[21][((size_t)g * 16 + c) * 64 + p]; cim[c] = P.in[22][((size_t)g * 16 + c) * 64 + p]; }
        asm volatile("" ::: "memory");
        lam[2 * gt] = (float)lr; lam[2 * gt + 1] = (float)li; lam64[2 * gt] = (float)pr; lam64[2 * gt + 1] = (float)pi;
        bf16* BBb = (bf16*)(ws + WS_BBB); bf16* Cmb = (bf16*)(ws + WS_CMB);
#pragma unroll
        for (int c = 0; c < 16; ++c) { const double br = brv[c >> 2][c & 3], bi = biv[c >> 2][c & 3]; const float xr = (float)(fre * br - fim * bi), xi = (float)(fre * bi + fim * br);
            BB[(size_t)gt * 32 + c] = xr; BB[(size_t)gt * 32 + 16 + c] = xi;
            BBb[((size_t)g * 128 + p) * 16 + c] = (bf16)f2bf(xr); BBb[((size_t)g * 128 + 64 + p) * 16 + c] = (bf16)f2bf(xi);
            Cmb[((size_t)g * 16 + c) * 128 + p] = (bf16)f2bf(cre[c]); Cmb[((size_t)g * 16 + c) * 128 + 64 + p] = (bf16)f2bf(-cim[c]); }
        (void)g; (void)p;
    }
}


namespace pg8 {
struct RowAff {
    const float* S1; const float* S2; const float* c1; const float* c2;
    __device__ __forceinline__ void cols(int col0, f32x4 (&c1v)[2][2], f32x4 (&c2v)[2][2]) const {
#pragma unroll
        for (int bj = 0; bj < 2; ++bj)
#pragma unroll
            for (int n = 0; n < 2; ++n) { c1v[bj][n] = *(const f32x4*)(c1 + col0 + bj * HALF + 4 * n); c2v[bj][n] = *(const f32x4*)(c2 + col0 + bj * HALF + 4 * n); }
    }
    __device__ __forceinline__ void row(int r, float& mu, float& rs) const { const float s1 = S1[r], s2 = S2[r]; mu = s1 * (1.0f / DM); rs = 1.0f / sqrtf(fmaxf(s2 * (1.0f / DM) - mu * mu, 0.f) + LN_EPS); }
    __device__ __forceinline__ void rows8(int row0, float (&mu)[2][4], float (&rs)[2][4]) const {
        float s1[2][4], s2[2][4];
#pragma unroll
        for (int ai = 0; ai < 2; ++ai)
#pragma unroll
            for (int m = 0; m < 4; ++m) { const int r = row0 + ai * HALF + m * 16; s1[ai][m] = S1[r]; s2[ai][m] = S2[r]; }
#pragma unroll
        for (int ai = 0; ai < 2; ++ai)
#pragma unroll
            for (int m = 0; m < 4; ++m) { mu[ai][m] = s1[ai][m] * (1.0f / DM); rs[ai][m] = 1.0f / sqrtf(fmaxf(s2[ai][m] * (1.0f / DM) - mu[ai][m] * mu[ai][m], 0.f) + LN_EPS); }
    }
};
template <bool AFF> struct EpiProjA {
    static constexpr bool PERM = true, AFTER_DRAIN = false;
    bf16_t* O; float* kp; float* vp; float* ks; float* vs; RowAff af;
    __device__ __forceinline__ void operator()(const f32x4 (&acc)[2][2][4][2], const Unit& u, int wr, int wc, int fr, int fq) const {
        const int row0 = u.pm * BM + wr * 64 + fr, colt = u.pn * BM, col0 = colt + wc * 32 + 8 * fq;
        const int sect = u.pn >> 2;
        const float sc = (sect == 0) ? SB_QSCALE : 1.0f;
        float* fbase = nullptr;
        if (sect == 1) fbase = (u.pm < NPM_P) ? kp + (size_t)row0 * 1024 : ks + (size_t)(row0 - MP) * 1024;
        if (sect == 2) fbase = (u.pm < NPM_P) ? vp + (size_t)row0 * 1024 : vs + (size_t)(row0 - MP) * 1024;
        const int fcol = col0 - sect * 1024;
        f32x4 c1v[2][2], c2v[2][2]; float mu8[2][4], rs8[2][4];
        if (AFF) { af.cols(col0, c1v, c2v); af.rows8(row0, mu8, rs8); }
#pragma unroll
        for (int ai = 0; ai < 2; ++ai)
#pragma unroll
            for (int m = 0; m < 4; ++m) { const int dr = ai * HALF + m * 16; bf16_t* rowp = O + (size_t)(row0 + dr) * 4096 + col0;
                float mu = 0.f, rs = 1.f; if (AFF) { mu = mu8[ai][m]; rs = rs8[ai][m]; }
#pragma unroll
                for (int bj = 0; bj < 2; ++bj) { f32x4 v0 = acc[ai][bj][m][0], v1 = acc[ai][bj][m][1];
                    if (AFF) { v0 = (v0 - c1v[bj][0] * mu) * rs + c2v[bj][0]; v1 = (v1 - c1v[bj][1] * mu) * rs + c2v[bj][1]; }
                    v0 = v0 * sc; v1 = v1 * sc;
                    u32x4 w; w.x = cvt_pk_bf16(v0[0], v0[1]); w.y = cvt_pk_bf16(v0[2], v0[3]); w.z = cvt_pk_bf16(v1[0], v1[1]); w.w = cvt_pk_bf16(v1[2], v1[3]);
                    *(u32x4*)(rowp + bj * HALF) = w;
                    if (fbase) { float* fp = fbase + (size_t)dr * 1024 + fcol + bj * HALF; *(f32x4*)fp = v0; *(f32x4*)(fp + 4) = v1; } } }
    }
};
struct EpiProjB {
    static constexpr bool PERM = true, AFTER_DRAIN = false;
    bf16_t* O; float* out; RowAff af;
    __device__ __forceinline__ void operator()(const f32x4 (&acc)[2][2][4][2], const Unit& u, int wr, int wc, int fr, int fq) const {
        const int row0 = u.pm * BM + wr * 64 + fr, colt = u.pn * BM, col0 = colt + wc * 32 + 8 * fq;
        const float sc = (u.pn < 8) ? 0.125f * 1.4426950408889634f : 1.0f;
        const bool kv = (u.pn == 8 || u.pn == 9);
        f32x4 c1v[2][2], c2v[2][2]; float mu8[2][4], rs8[2][4];
        af.cols(col0, c1v, c2v); af.rows8(row0, mu8, rs8);
#pragma unroll
        for (int ai = 0; ai < 2; ++ai)
#pragma unroll
            for (int m = 0; m < 4; ++m) { const int row = row0 + ai * HALF + m * 16; bf16_t* rowp = O + (size_t)row * 4608 + col0;
                const float mu = mu8[ai][m], rs = rs8[ai][m];
                float* fp = nullptr;
                if (kv) {
                    if (row >= MP) fp = out + (u.pn == 8 ? O_KBS : O_VBS) + (size_t)(row - MP) * 256;
                    else { const int b = row / SEQ, t = row % SEQ; if (t >= SEQ - 128) fp = out + (u.pn == 8 ? O_KBP : O_VBP) + ((size_t)b * 128 + (t - (SEQ - 128))) * 256; }
                    if (fp) fp += (col0 - colt);
                }
#pragma unroll
                for (int bj = 0; bj < 2; ++bj) { f32x4 v0 = acc[ai][bj][m][0], v1 = acc[ai][bj][m][1];
                    v0 = ((v0 - c1v[bj][0] * mu) * rs + c2v[bj][0]) * sc; v1 = ((v1 - c1v[bj][1] * mu) * rs + c2v[bj][1]) * sc;
                    u32x4 w; w.x = cvt_pk_bf16(v0[0], v0[1]); w.y = cvt_pk_bf16(v0[2], v0[3]); w.z = cvt_pk_bf16(v1[0], v1[1]); w.w = cvt_pk_bf16(v1[2], v1[3]);
                    *(u32x4*)(rowp + bj * HALF) = w;
                    if (fp) { *(f32x4*)(fp + bj * HALF) = v0; *(f32x4*)(fp + bj * HALF + 4) = v1; } } }
    }
};
struct EpiProjC {
    static constexpr bool PERM = true, AFTER_DRAIN = false;
    bf16_t* O; RowAff af;
    __device__ __forceinline__ void operator()(const f32x4 (&acc)[2][2][4][2], const Unit& u, int wr, int wc, int fr, int fq) const {
        const int row0 = u.pm * BM + wr * 64 + fr, col0 = u.pn * BM + wc * 32 + 8 * fq;
        f32x4 c1v[2][2], c2v[2][2]; float mu8[2][4], rs8[2][4];
        af.cols(col0, c1v, c2v); af.rows8(row0, mu8, rs8);
#pragma unroll
        for (int ai = 0; ai < 2; ++ai)
#pragma unroll
            for (int m = 0; m < 4; ++m) { const int row = row0 + ai * HALF + m * 16; bf16_t* rowp = O + (size_t)row * 2048 + col0;
                const float mu = mu8[ai][m], rs = rs8[ai][m];
#pragma unroll
                for (int bj = 0; bj < 2; ++bj) { const f32x4 v0 = (acc[ai][bj][m][0] - c1v[bj][0] * mu) * rs + c2v[bj][0], v1 = (acc[ai][bj][m][1] - c1v[bj][1] * mu) * rs + c2v[bj][1];
                    u32x4 w; w.x = cvt_pk_bf16(v0[0], v0[1]); w.y = cvt_pk_bf16(v0[2], v0[3]); w.z = cvt_pk_bf16(v1[0], v1[1]); w.w = cvt_pk_bf16(v1[2], v1[3]);
                    *(u32x4*)(rowp + bj * HALF) = w; } }
    }
};
struct EpiResid {
    static constexpr bool PERM = false, AFTER_DRAIN = false;
    const float* xp; const float* xs; float* Z;
    __device__ __forceinline__ void operator()(const f32x4 (&acc)[2][2][4][2], const Unit& u, int wr, int wc, int fr, int fq) const {
        const int row0 = u.pm * BM + wr * 64 + fr, col0 = u.pn * BM + wc * 32 + 4 * fq;
        const float* xb = (u.pm < NPM_P) ? xp + (size_t)row0 * DM : xs + (size_t)(row0 - MP) * DM;
        float* zb = Z + (size_t)row0 * DM;
#pragma unroll
        for (int ai = 0; ai < 2; ++ai)
#pragma unroll
            for (int m = 0; m < 4; ++m) { const size_t off = (size_t)(ai * HALF + m * 16) * DM + col0;
#pragma unroll
                for (int bj = 0; bj < 2; ++bj)
#pragma unroll
                    for (int n = 0; n < 2; ++n) { const f32x4 xv = *(const f32x4*)(xb + off + bj * HALF + n * 16); *(f32x4*)(zb + off + bj * HALF + n * 16) = xv * ALPHA + acc[ai][bj][m][n]; } }
    }
};
struct EpiGlu {
    static constexpr bool PERM = true, AFTER_DRAIN = false;
    const bf16_t* Y1; const bf16_t* PROJ; bf16_t* O;
    __device__ __forceinline__ void operator()(const f32x4 (&acc)[2][2][4][2], const Unit& u, int wr, int wc, int fr, int fq) const {
        const int row0 = u.pm * BM + wr * 64 + fr, col0 = u.pn * BM + wc * 32 + 8 * fq;
#pragma unroll
        for (int ai = 0; ai < 2; ++ai)
#pragma unroll
            for (int mp = 0; mp < 4; mp += 2) {
                u32x4 yv[2][2], gv[2][2];
#pragma unroll
                for (int mm = 0; mm < 2; ++mm) { const size_t row = (size_t)(row0 + ai * HALF + (mp + mm) * 16);
#pragma unroll
                    for (int bj = 0; bj < 2; ++bj) { const int c = col0 + bj * HALF; yv[mm][bj] = *(const u32x4*)(Y1 + row * 1024 + c); gv[mm][bj] = *(const u32x4*)(PROJ + row * 2048 + 1024 + c); } }
                asm volatile("" ::: "memory");
#pragma unroll
                for (int mm = 0; mm < 2; ++mm) { const int m = mp + mm; const size_t row = (size_t)(row0 + ai * HALF + m * 16);
#pragma unroll
                    for (int bj = 0; bj < 2; ++bj) { const int c = col0 + bj * HALF;
                        float r[8];
#pragma unroll
                        for (int e = 0; e < 8; ++e) { const float a = (e < 4) ? acc[ai][bj][m][0][e] : acc[ai][bj][m][1][e - 4];
                            const unsigned yw = yv[mm][bj][e >> 1], gw = gv[mm][bj][e >> 1]; const float y = (e & 1) ? __uint_as_float(yw & 0xffff0000u) : __uint_as_float(yw << 16);
                            const float g = (e & 1) ? __uint_as_float(gw & 0xffff0000u) : __uint_as_float(gw << 16);
                            r[e] = y / (1.0f + __expf(-a)) * (g / (1.0f + __expf(-g))); }
                        u32x4 w; w.x = cvt_pk_bf16(r[0], r[1]); w.y = cvt_pk_bf16(r[2], r[3]); w.z = cvt_pk_bf16(r[4], r[5]); w.w = cvt_pk_bf16(r[6], r[7]);
                        *(u32x4*)(O + row * 1024 + c) = w; } } }
    }
};
template <bool F32OUT, bool AFF, bool STATS> struct EpiResidB {
    static constexpr bool PERM = true, AFTER_DRAIN = false;
    const bf16_t* X; bf16_t* Z; float* ZF; const float* S1p; const float* S2p; const float* g; const float* b; float* S1n; float* S2n;
    __device__ __forceinline__ void operator()(const f32x4 (&acc)[2][2][4][2], const Unit& u, int wr, int wc, int fr, int fq) const {
        const int row0 = u.pm * BM + wr * 64 + fr, col0 = u.pn * BM + wc * 32 + 8 * fq;
        f32x4 gv[2][2], bv[2][2];
        if (AFF) {
#pragma unroll
            for (int bj = 0; bj < 2; ++bj)
#pragma unroll
                for (int n = 0; n < 2; ++n) { gv[bj][n] = *(const f32x4*)(g + col0 + bj * HALF + 4 * n); bv[bj][n] = *(const f32x4*)(b + col0 + bj * HALF + 4 * n); }
        }
        float rs1[2][4], rs2[2][4];
#pragma unroll
        for (int ai = 0; ai < 2; ++ai) {
            u32x4 xr[4][2]; float s1r[4], s2r[4];
#pragma unroll
            for (int m = 0; m < 4; ++m) { const int row = row0 + ai * HALF + m * 16; const size_t off = (size_t)row * DM + col0;
                if (AFF) { s1r[m] = S1p[row]; s2r[m] = S2p[row]; }
#pragma unroll
                for (int bj = 0; bj < 2; ++bj) xr[m][bj] = *(const u32x4*)(X + off + bj * HALF); }
            asm volatile("" ::: "memory");
#pragma unroll
            for (int m = 0; m < 4; ++m) { const int row = row0 + ai * HALF + m * 16; const size_t off = (size_t)row * DM + col0;
                float mu = 0.f, rs = 1.f;
                if (AFF) { mu = s1r[m] * (1.0f / DM); rs = 1.0f / sqrtf(fmaxf(s2r[m] * (1.0f / DM) - mu * mu, 0.f) + LN_EPS); }
                float p1 = 0.f, p2 = 0.f;
#pragma unroll
                for (int bj = 0; bj < 2; ++bj) { const u32x4 xv = xr[m][bj];
                    f32x4 x0 = {__uint_as_float(xv[0] << 16), __uint_as_float(xv[0] & 0xffff0000u), __uint_as_float(xv[1] << 16), __uint_as_float(xv[1] & 0xffff0000u)};
                    f32x4 x1 = {__uint_as_float(xv[2] << 16), __uint_as_float(xv[2] & 0xffff0000u), __uint_as_float(xv[3] << 16), __uint_as_float(xv[3] & 0xffff0000u)};
                    if (AFF) { x0 = (x0 - mu) * rs * gv[bj][0] + bv[bj][0]; x1 = (x1 - mu) * rs * gv[bj][1] + bv[bj][1]; }
                    const f32x4 r0 = x0 * ALPHA + acc[ai][bj][m][0], r1 = x1 * ALPHA + acc[ai][bj][m][1];
                    if (STATS) { p1 += ((r0[0] + r0[1]) + (r0[2] + r0[3])) + ((r1[0] + r1[1]) + (r1[2] + r1[3]));
                        p2 += ((r0[0] * r0[0] + r0[1] * r0[1]) + (r0[2] * r0[2] + r0[3] * r0[3])) + ((r1[0] * r1[0] + r1[1] * r1[1]) + (r1[2] * r1[2] + r1[3] * r1[3])); }
                    if (F32OUT) { *(f32x4*)(ZF + off + bj * HALF) = r0; *(f32x4*)(ZF + off + bj * HALF + 4) = r1; }
                    else { u32x4 w; w.x = cvt_pk_bf16(r0[0], r0[1]); w.y = cvt_pk_bf16(r0[2], r0[3]); w.z = cvt_pk_bf16(r1[0], r1[1]); w.w = cvt_pk_bf16(r1[2], r1[3]); *(u32x4*)(Z + off + bj * HALF) = w; } }
                if (STATS) { p1 += __shfl_xor(p1, 16); p2 += __shfl_xor(p2, 16); p1 += __shfl_xor(p1, 32); p2 += __shfl_xor(p2, 32); rs1[ai][m] = p1; rs2[ai][m] = p2; } }
        }
        if (STATS) {
#pragma unroll
            for (int ai = 0; ai < 2; ++ai) { const float a1 = fq == 0 ? rs1[ai][0] : fq == 1 ? rs1[ai][1] : fq == 2 ? rs1[ai][2] : rs1[ai][3], a2 = fq == 0 ? rs2[ai][0] : fq == 1 ? rs2[ai][1] : fq == 2 ? rs2[ai][2] : rs2[ai][3];
                const int row = u.pm * BM + ai * HALF + wr * 64 + fq * 16 + fr;
                const float o1 = unsafeAtomicAdd(S1n + row, a1), o2 = unsafeAtomicAdd(S2n + row, a2);
                asm volatile("" :: "v"(o1), "v"(o2)); }
        }
    }
};
}

__device__ __forceinline__ void ln_phase(Frame& F, const float* Z, float* xf, bf16* XB, const float* g, const float* b) {
    const int gw = F.vcu * NWAVES + F.wave, NGW = F.G * NWAVES;
    for (int m = gw; m < M; m += NGW) {
        const GAS f32x4* zr = (const GAS f32x4*)(Z + (size_t)m * DM);
        f32x4 v[8]; float s = 0.f;
#pragma unroll
        for (int j = 0; j < 8; ++j) { v[j] = zr[(j >> 1) * 128 + F.lane * 2 + (j & 1)]; s += (v[j].x + v[j].y) + (v[j].z + v[j].w); }
        const float mean = wave_sum(s) * (1.f / DM); float s2 = 0.f;
#pragma unroll
        for (int j = 0; j < 8; ++j) { v[j] = v[j] - mean; s2 += (v[j].x * v[j].x + v[j].y * v[j].y) + (v[j].z * v[j].z + v[j].w * v[j].w); }
        const float rstd = 1.f / sqrtf(wave_sum(s2) * (1.f / DM) + LN_EPS);
        GAS f32x4* xr = (GAS f32x4*)(xf + (size_t)m * DM);
#pragma unroll
        for (int j = 0; j < 4; ++j) { const int c4 = j * 128 + F.lane * 2;
            const f32x4 g0 = *(const GAS f32x4*)(g + 4 * c4), g1 = *(const GAS f32x4*)(g + 4 * c4 + 4), b0 = *(const GAS f32x4*)(b + 4 * c4), b1 = *(const GAS f32x4*)(b + 4 * c4 + 4);
            const f32x4 o0 = v[2 * j] * rstd * g0 + b0, o1 = v[2 * j + 1] * rstd * g1 + b1;
            xr[c4] = o0; xr[c4 + 1] = o1;
            v4u o; o.x = pk2(o0.x, o0.y); o.y = pk2(o0.z, o0.w); o.z = pk2(o1.x, o1.y); o.w = pk2(o1.z, o1.w); *(GAS v4u*)(XB + (size_t)m * DM + 4 * c4) = o; }
    }
}

__device__ __forceinline__ void ln_phase_b(Frame& F, bf16* XB, const float* g, const float* b) {
    const int gw = F.vcu * NWAVES + F.wave, NGW = F.G * NWAVES;
    f32x4 gg[8], bb[8];
#pragma unroll
    for (int j = 0; j < 4; ++j) { const int c = (j * 64 + F.lane) * 8; gg[2 * j] = *(const GAS f32x4*)(g + c); gg[2 * j + 1] = *(const GAS f32x4*)(g + c + 4); bb[2 * j] = *(const GAS f32x4*)(b + c); bb[2 * j + 1] = *(const GAS f32x4*)(b + c + 4); }
    for (int m0 = 2 * gw; m0 < M; m0 += 2 * NGW) {
        v4u raw[2][4];
#pragma unroll
        for (int r = 0; r < 2; ++r)
#pragma unroll
            for (int j = 0; j < 4; ++j) raw[r][j] = *(const GAS v4u*)(XB + (size_t)(m0 + r) * DM + (j * 64 + F.lane) * 8);
#pragma unroll
        for (int r = 0; r < 2; ++r) {
            f32x4 v[8]; float s = 0.f;
#pragma unroll
            for (int j = 0; j < 4; ++j) { const v4u w = raw[r][j]; v[2 * j] = (f32x4){bflo(w.x), bfhi(w.x), bflo(w.y), bfhi(w.y)}; v[2 * j + 1] = (f32x4){bflo(w.z), bfhi(w.z), bflo(w.w), bfhi(w.w)};
                s += (v[2 * j].x + v[2 * j].y) + (v[2 * j].z + v[2 * j].w) + (v[2 * j + 1].x + v[2 * j + 1].y) + (v[2 * j + 1].z + v[2 * j + 1].w); }
            const float mean = wave_sum(s) * (1.f / DM); float s2 = 0.f;
#pragma unroll
            for (int j = 0; j < 8; ++j) { v[j] = v[j] - mean; s2 += (v[j].x * v[j].x + v[j].y * v[j].y) + (v[j].z * v[j].z + v[j].w * v[j].w); }
            const float rstd = 1.f / sqrtf(wave_sum(s2) * (1.f / DM) + LN_EPS);
#pragma unroll
            for (int j = 0; j < 4; ++j) { const f32x4 o0 = v[2 * j] * rstd * gg[2 * j] + bb[2 * j], o1 = v[2 * j + 1] * rstd * gg[2 * j + 1] + bb[2 * j + 1];
                v4u o; o.x = pk2(o0.x, o0.y); o.y = pk2(o0.z, o0.w); o.z = pk2(o1.x, o1.y); o.w = pk2(o1.z, o1.w); *(GAS v4u*)(XB + (size_t)(m0 + r) * DM + (j * 64 + F.lane) * 8) = o; }
        }
    }
}
__device__ __forceinline__ void ln_phase_final(Frame& F, const bf16* Z, const float* S1, const float* S2, float* out, const float* g, const float* b, int m_lo, int m_hi, int gw, int NGW) {
    f32x4 gg[8], bb[8];
#pragma unroll
    for (int j = 0; j < 4; ++j) { const int c = (j * 64 + F.lane) * 8; gg[2 * j] = *(const GAS f32x4*)(g + c); gg[2 * j + 1] = *(const GAS f32x4*)(g + c + 4); bb[2 * j] = *(const GAS f32x4*)(b + c); bb[2 * j + 1] = *(const GAS f32x4*)(b + c + 4); }
    for (int m0 = m_lo + 2 * gw; m0 < m_hi; m0 += 2 * NGW) {
        v4u raw[2][4]; float mu[2], rs[2];
#pragma unroll
        for (int r = 0; r < 2; ++r) {
#pragma unroll
            for (int j = 0; j < 4; ++j) raw[r][j] = *(const GAS v4u*)(Z + (size_t)(m0 + r) * DM + (j * 64 + F.lane) * 8);
            const float s1 = S1[m0 + r], s2 = S2[m0 + r]; mu[r] = s1 * (1.0f / DM); rs[r] = 1.0f / sqrtf(fmaxf(s2 * (1.0f / DM) - mu[r] * mu[r], 0.f) + LN_EPS); }
#pragma unroll
        for (int r = 0; r < 2; ++r)
#pragma unroll
            for (int j = 0; j < 4; ++j) { const v4u w = raw[r][j];
                const f32x4 v0 = {bflo(w.x), bfhi(w.x), bflo(w.y), bfhi(w.y)}, v1 = {bflo(w.z), bfhi(w.z), bflo(w.w), bfhi(w.w)};
                GAS f32x4* o = (GAS f32x4*)(out + (size_t)(m0 + r) * DM + (j * 64 + F.lane) * 8);
                o[0] = (v0 - mu[r]) * rs[r] * gg[2 * j] + bb[2 * j]; o[1] = (v1 - mu[r]) * rs[r] * gg[2 * j + 1] + bb[2 * j + 1]; }
    }
}
__device__ __forceinline__ float tr_reduce16(const float (&v)[16], int lane) {
    float a[8], b[4], c[2];
    const bool b5 = lane & 32, b4 = lane & 16, b3 = lane & 8, b2 = lane & 4;
#pragma unroll
    for (int i = 0; i < 8; ++i) { const float send = b5 ? v[i] : v[i + 8], keep = b5 ? v[i + 8] : v[i]; a[i] = keep + __shfl_xor(send, 32); }
#pragma unroll
    for (int i = 0; i < 4; ++i) { const float send = b4 ? a[i] : a[i + 4], keep = b4 ? a[i + 4] : a[i]; b[i] = keep + __shfl_xor(send, 16); }
#pragma unroll
    for (int i = 0; i < 2; ++i) { const float send = b3 ? b[i] : b[i + 2], keep = b3 ? b[i + 2] : b[i]; c[i] = keep + __shfl_xor(send, 8); }
    const float send = b2 ? c[0] : c[1], keep = b2 ? c[1] : c[0];
    float d = keep + __shfl_xor(send, 4);
    d += __shfl_xor(d, 2); d += __shfl_xor(d, 1);
    return d;
}
template <bool FULL>
__device__ __forceinline__ void s5_block(Frame& F, const Ptrs& P, const bf16* PROJ, bf16* Y1, size_t row0, int T, int g, float& hr, float& hi) {
    LAS float* ub = (LAS float*)(F.lds + RING_OFF + F.wave * 8192);
    LAS float* yb = ub + 1024;
    const int lane = F.lane;
    const float* lam = (const float*)(P.ws + WS_SSMC); const float* BB = lam + 2 * 64 * 64 * 2;
    const int gp = g * 64 + lane;
    const float lr = lam[2 * gp], li = lam[2 * gp + 1];
    float br[16], bi[16];
#pragma unroll
    for (int c = 0; c < 4; ++c) { const f32x4 x = *(const GAS f32x4*)(BB + (size_t)gp * 32 + 4 * c), y = *(const GAS f32x4*)(BB + (size_t)gp * 32 + 16 + 4 * c);
        br[4 * c] = x.x; br[4 * c + 1] = x.y; br[4 * c + 2] = x.z; br[4 * c + 3] = x.w; bi[4 * c] = y.x; bi[4 * c + 1] = y.y; bi[4 * c + 2] = y.z; bi[4 * c + 3] = y.w; }
    float cr[16], ci[16];
    if (FULL) {
#pragma unroll
        for (int c = 0; c < 16; ++c) { cr[c] = P.in[21][(size_t)(g * 16 + c) * 64 + lane]; ci[c] = P.in[22][(size_t)(g * 16 + c) * 64 + lane]; }
    }
    if (lane < T) { const GAS v4u* ur = (const GAS v4u*)(PROJ + (row0 + lane) * 2048 + g * 16); const v4u a = ur[0], b = ur[1];
        LAS f32x4* d = (LAS f32x4*)(ub + lane * 16);
        d[0] = (f32x4){bflo(a.x), bfhi(a.x), bflo(a.y), bfhi(a.y)}; d[1] = (f32x4){bflo(a.z), bfhi(a.z), bflo(a.w), bfhi(a.w)};
        d[2] = (f32x4){bflo(b.x), bfhi(b.x), bflo(b.y), bfhi(b.y)}; d[3] = (f32x4){bflo(b.z), bfhi(b.z), bflo(b.w), bfhi(b.w)}; }
    LDS_WAIT(); asm volatile("" ::: "memory");
    for (int t = 0; t < T; ++t) {
        float u[16];
#pragma unroll
        for (int c = 0; c < 4; ++c) { const f32x4 x = *(const LAS f32x4*)(ub + t * 16 + 4 * c); u[4 * c] = x.x; u[4 * c + 1] = x.y; u[4 * c + 2] = x.z; u[4 * c + 3] = x.w; }
        float bur = 0.f, bui = 0.f;
#pragma unroll
        for (int c = 0; c < 16; ++c) { bur += u[c] * br[c]; bui += u[c] * bi[c]; }
        const float nr = lr * hr - li * hi + bur, ni = lr * hi + li * hr + bui;
        hr = nr; hi = ni;
        if (FULL) {
            float v[16];
#pragma unroll
            for (int c = 0; c < 16; ++c) v[c] = hr * cr[c] - hi * ci[c];
            const float y = tr_reduce16(v, lane);
            if ((lane & 3) == 0) yb[t * 16 + (((lane >> 5) & 1) * 8 + ((lane >> 4) & 1) * 4 + ((lane >> 3) & 1) * 2 + ((lane >> 2) & 1))] = y;
        }
    }
    if (FULL) {
        LDS_WAIT(); asm volatile("" ::: "memory");
        if (lane < T) {
            float r[16];
#pragma unroll
            for (int c = 0; c < 16; ++c) { const float y = yb[lane * 16 + c] + P.in[23][g * 16 + c] * ub[lane * 16 + c]; r[c] = gelu_tanh_f(y); }
            v4u a, b; a.x = pk2(r[0], r[1]); a.y = pk2(r[2], r[3]); a.z = pk2(r[4], r[5]); a.w = pk2(r[6], r[7]); b.x = pk2(r[8], r[9]); b.y = pk2(r[10], r[11]); b.z = pk2(r[12], r[13]); b.w = pk2(r[14], r[15]);
            GAS v4u* o = (GAS v4u*)(Y1 + (row0 + lane) * 1024 + g * 16); o[0] = a; o[1] = b;
        }
    }
    LDS_WAIT(); asm volatile("" ::: "memory");
}
__device__ __forceinline__ void s5_local(Frame& F, const Ptrs& P, const bf16* PROJ) {
    float* SEND = (float*)(P.ws + WS_SEND);
    for (int i = 0;; ++i) { const int item = (i * F.G + F.vcu) * NWAVES + F.wave; if (item >= 2 * 256 * 64) break;
        const int g = item & 63, bc = item >> 6;
        float hr = 0.f, hi = 0.f;
        s5_block<false>(F, P, PROJ, nullptr, (size_t)bc * 64, 64, g, hr, hi);
        SEND[((size_t)bc * 64 + g) * 128 + F.lane] = hr; SEND[((size_t)bc * 64 + g) * 128 + 64 + F.lane] = hi; }
}
__device__ __forceinline__ void s5_carry(Frame& F, const Ptrs& P) {
    const int gt = F.vcu * (NWAVES * 64) + F.tid;
    if (gt >= 2 * 64 * 64) return;
    const int b = gt >> 12, gp = gt & 4095, g = gp >> 6, p = gp & 63;
    const float* SEND = (const float*)(P.ws + WS_SEND); float* HIN = (float*)(P.ws + WS_HIN);
    const float* lam64 = (const float*)(P.ws + WS_SSMC) + 64 * 64 * 2;
    const float lr = lam64[2 * gp], li = lam64[2 * gp + 1];
    float hr = 0.f, hi = 0.f;
    for (int c0 = 0; c0 < 256; c0 += 8) {
        float sr[8], si[8];
#pragma unroll
        for (int k = 0; k < 8; ++k) { const size_t o = (((size_t)b * 256 + c0 + k) * 64 + g) * 128 + p; sr[k] = SEND[o]; si[k] = SEND[o + 64]; }
#pragma unroll
        for (int k = 0; k < 8; ++k) { const size_t o = (((size_t)b * 256 + c0 + k) * 64 + g) * 128 + p; HIN[o] = hr; HIN[o + 64] = hi;
            const float nr = lr * hr - li * hi + sr[k], ni = lr * hi + li * hr + si[k]; hr = nr; hi = ni; }
    }
    P.out[O_HRP + (size_t)b * 4096 + gp] = hr; P.out[O_HIP + (size_t)b * 4096 + gp] = hi;
}
__device__ __forceinline__ void s5_full(Frame& F, const Ptrs& P, const bf16* PROJ, bf16* Y1) {
    const float* HIN = (const float*)(P.ws + WS_HIN);
    constexpr int NP = 2 * 256 * 64, NS = 32 * 64;
    for (int i = 0;; ++i) { const int item = (i * F.G + F.vcu) * NWAVES + F.wave; if (item >= NP + NS) break;
        if (item < NP) { const int g = item & 63, bc = item >> 6;
            float hr = HIN[((size_t)bc * 64 + g) * 128 + F.lane], hi = HIN[((size_t)bc * 64 + g) * 128 + 64 + F.lane];
            s5_block<true>(F, P, PROJ, Y1, (size_t)bc * 64, 64, g, hr, hi);
        } else { const int it = item - NP, g = it & 63, b = it >> 6;
            float hr = P.in[6][((size_t)b * 64 + g) * 64 + F.lane], hi = P.in[7][((size_t)b * 64 + g) * 64 + F.lane];
            s5_block<true>(F, P, PROJ, Y1, (size_t)MP + b * 32, 32, g, hr, hi);
            P.out[O_HRS + ((size_t)b * 64 + g) * 64 + F.lane] = hr; P.out[O_HIS + ((size_t)b * 64 + g) * 64 + F.lane] = hi; }
    }
}


__device__ __forceinline__ int opq(int x) { asm volatile("" : "+v"(x)); return x; }
typedef short s16x4 __attribute__((ext_vector_type(4)));
typedef unsigned u32x2v __attribute__((ext_vector_type(2)));
typedef short v4i16_t __attribute__((ext_vector_type(4)));
typedef float f32x16 __attribute__((ext_vector_type(16)));
typedef __bf16 bf16x2_t __attribute__((ext_vector_type(2)));
__device__ __forceinline__ unsigned cvtpk(float lo, float hi) { f32x2v v = {lo, hi}; bf16x2_t b = __builtin_convertvector(v, bf16x2_t); return __builtin_bit_cast(unsigned, b); }
__device__ __forceinline__ s16x4 vtr(const LAS unsigned char* p) { return __builtin_bit_cast(s16x4, __builtin_amdgcn_ds_read_tr16_b64_v4i16((LAS v4i16_t*)p)); }
__device__ __forceinline__ bf16x8 vtr2(const LAS unsigned char* p0, const LAS unsigned char* p1) { const s16x4 lo = vtr(p0), hi = vtr(p1); return __builtin_shufflevector(lo, hi, 0, 1, 2, 3, 4, 5, 6, 7); }
__device__ __forceinline__ unsigned off128(unsigned row, unsigned ch) { return 256u * row + 16u * (ch ^ (((row & 3) << 2) | ((row >> 2) & 3))); }
__device__ __forceinline__ unsigned off64(unsigned row, unsigned ch) { const unsigned a = row >> 1; return 128u * row + 16u * (ch ^ (((a & 1) << 2) | ((a >> 1) & 3))); }
#define MFMA32(a, b, c) __builtin_amdgcn_mfma_f32_32x32x16_bf16((a), (b), (c), 0, 0, 0)
__device__ __forceinline__ v4u pack8(const f32x4 a, const f32x4 b) { v4u o; o.x = cvtpk(a.x, a.y); o.y = cvtpk(a.z, a.w); o.z = cvtpk(b.x, b.y); o.w = cvtpk(b.z, b.w); return o; }

__device__ __forceinline__ void glds16(const void* gsrc, unsigned lds_dst) { unsigned keep;
    asm volatile("s_mov_b32 %0, m0\n\ts_mov_b32 m0, %2\n\ts_nop 0\n\tglobal_load_lds_dwordx4 %1, off\n\ts_mov_b32 m0, %0" : "=&s"(keep) : "v"(gsrc), "s"(lds_dst) : "memory"); }
#define GLDS16(gptr, ldsptr) glds16((const void*)(gptr), (unsigned)(size_t)(ldsptr))
__device__ __forceinline__ void glds16s(const void* sbase, unsigned voff, unsigned lds_dst) { unsigned keep;
    asm volatile("s_mov_b32 %0, m0\n\ts_mov_b32 m0, %3\n\ts_nop 4\n\tglobal_load_lds_dwordx4 %1, %2\n\ts_mov_b32 m0, %0" : "=&s"(keep) : "v"(voff), "s"(sbase), "s"(lds_dst) : "memory"); }
#define VMW(n) asm volatile("s_waitcnt vmcnt(" #n ")" ::: "memory")
#define LGW0() asm volatile("s_waitcnt lgkmcnt(0)" ::: "memory")
#define SCHEDB() __builtin_amdgcn_sched_barrier(0)
__device__ __forceinline__ float silu_fast(float g) { return g * __builtin_amdgcn_rcpf(1.0f + __builtin_amdgcn_exp2f(-1.4426950408889634f * g)); }
__device__ __forceinline__ void sb_tile_weights(const f32x16& s, int lane, bool diag, float& later, bf16x8& p0, bf16x8& p1) {
    const int j = lane & 31, h = lane >> 5;
    const int lim = diag ? j : 64;
    float l[16];
#pragma unroll
    for (int r = 0; r < 16; ++r) { const int kk = (r & 3) + 8 * (r >> 2) + 4 * h; const float z = s[r];
        const float sp = fmaxf(z, 0.f) + __builtin_amdgcn_logf(1.0f + __builtin_amdgcn_exp2f(-fabsf(z))); l[r] = (kk < lim) ? -sp : 0.f; }
    float A[4], PA[4];
#pragma unroll
    for (int g = 0; g < 4; ++g) { l[4 * g + 2] += l[4 * g + 3]; l[4 * g + 1] += l[4 * g + 2]; l[4 * g] += l[4 * g + 1]; A[g] = l[4 * g]; PA[g] = __shfl_xor(A[g], 32); }
    float T[4]; T[3] = 0.f; T[2] = A[3] + PA[3]; T[1] = T[2] + A[2] + PA[2]; T[0] = T[1] + A[1] + PA[1];
    const float total = T[0] + A[0] + PA[0];
    unsigned pw[8];
#pragma unroll
    for (int g = 0; g < 4; ++g) { const float base = later + T[g] + (h == 0 ? PA[g] : 0.f); float w[4];
#pragma unroll
        for (int e = 0; e < 4; ++e) { const int r = 4 * g + e; const int kk = e + 8 * g + 4 * h; w[e] = (kk < lim) ? __builtin_amdgcn_exp2f(s[r] + l[r] + base) : 0.f; }
        pw[2 * g] = cvtpk(w[0], w[1]); pw[2 * g + 1] = cvtpk(w[2], w[3]); }
    later += total;
    p0 = __builtin_bit_cast(bf16x8, (v4u){pw[0], pw[1], pw[2], pw[3]}); p1 = __builtin_bit_cast(bf16x8, (v4u){pw[4], pw[5], pw[6], pw[7]});
}
__device__ __forceinline__ void sb_tile_pv(const LAS unsigned char* Vimg, int lane, const bf16x8& p0, const bf16x8& p1, f32x16 (&o)[4]) {
    const int h = lane >> 5, blk = (lane >> 4) & 1, q4 = (lane & 15) >> 2, p4 = lane & 3;
#pragma unroll
    for (int c = 0; c < 4; ++c) {
        const unsigned a0 = off128(4 * h + q4, 4 * c + 2 * blk + (p4 >> 1)) + 8 * (p4 & 1), a1 = off128(8 + 4 * h + q4, 4 * c + 2 * blk + (p4 >> 1)) + 8 * (p4 & 1);
        const bf16x8 v0 = vtr2(Vimg + a0, Vimg + a1), v1 = vtr2(Vimg + a0 + 4096, Vimg + a1 + 4096);
        o[c] = MFMA32(v0, p0, o[c]); o[c] = MFMA32(v1, p1, o[c]); }
}
typedef __amdgpu_buffer_rsrc_t rsrc_t;
__device__ __forceinline__ rsrc_t mk_rsrc(const void* p) { return __builtin_amdgcn_make_buffer_rsrc((void*)p, (short)0, 0x7fffffff, 0x00020000); }
__device__ __forceinline__ void dma_tile128(LAS unsigned char* img, const char* tilebase, const unsigned (&voff)[4]) {
#pragma unroll
    for (int i = 0; i < 8; ++i) glds16s(tilebase + (size_t)i * 32768, voff[i & 3], (unsigned)(size_t)(img + i * 1024));
}
template <bool sample>
__device__ __forceinline__ void sb_item(Frame& F, const bf16* PROJ, const float* cache_k, const float* cache_v, bf16* AO, const int b, const int hh, const int kt0, const size_t m0) {
    LAS unsigned char* Kimg = F.lds + RING_OFF + F.wave * 16384;
    LAS unsigned char* Vimg = Kimg + 8192;
    const int lane = F.lane, j = lane & 31, h = lane >> 5;
    const int srow = lane >> 4, sch = lane & 15;
    unsigned voff[4];
#pragma unroll
    for (int v = 0; v < 4; ++v) voff[v] = (unsigned)srow * 8192u + (unsigned)((sch ^ (srow << 2)) ^ v) * 16u;
    const rsrc_t rsO = mk_rsrc(AO), rsCK = mk_rsrc(cache_k), rsCV = mk_rsrc(cache_v);
    const unsigned vso = (unsigned)(srow * 1024 + sch * 8) * 2u, vsc = (unsigned)(srow * 1024 + sch * 8) * 4u;
    {
        const char* qb = (const char*)(PROJ + m0 * 4096 + hh * 128);
        const char* kvb = (const char*)(PROJ + (sample ? m0 : (size_t)b * SEQ) * 4096 + 1024 + hh * 128);
        LGW0();
        dma_tile128(Vimg, qb, voff);
        dma_tile128(Kimg, kvb + (sample ? 0 : (size_t)kt0 * 262144), voff);
        VMW(8);
        bf16x8 qf[8];
#pragma unroll
        for (int ks = 0; ks < 8; ++ks) qf[ks] = *(const LAS bf16x8*)(Vimg + off128(j, 2 * ks + h));
        LGW0(); SCHEDB();
        dma_tile128(Vimg, kvb + (sample ? 0 : (size_t)kt0 * 262144) + 2048, voff);
        f32x16 o[4];
#pragma unroll
        for (int c = 0; c < 4; ++c)
#pragma unroll
            for (int r = 0; r < 16; ++r) o[c][r] = 0.f;
        float later = 0.f;
        for (int kt = kt0; kt >= 0; --kt) {
            const bool diag = (kt == kt0);
            if (sample && !diag) {
                const unsigned cbu = ((((unsigned)b * PAST + 32u * (unsigned)kt) * 8u + (unsigned)hh) * 128u) * 4u;
                LGW0();
                { f32x4 t0[8], t1[8];
#pragma unroll
                  for (int i = 0; i < 8; ++i) { t0[i] = __builtin_bit_cast(f32x4, __builtin_amdgcn_raw_buffer_load_b128(rsCK, (int)vsc, (int)(cbu + i * 16384), 0)); t1[i] = __builtin_bit_cast(f32x4, __builtin_amdgcn_raw_buffer_load_b128(rsCK, (int)vsc, (int)(cbu + i * 16384 + 16), 0)); }
#pragma unroll
                  for (int i = 0; i < 8; ++i) *(LAS v4u*)(Kimg + off128(srow + 4 * i, sch)) = pack8(t0[i], t1[i]); }
                { f32x4 t0[8], t1[8];
#pragma unroll
                  for (int i = 0; i < 8; ++i) { t0[i] = __builtin_bit_cast(f32x4, __builtin_amdgcn_raw_buffer_load_b128(rsCV, (int)vsc, (int)(cbu + i * 16384), 0)); t1[i] = __builtin_bit_cast(f32x4, __builtin_amdgcn_raw_buffer_load_b128(rsCV, (int)vsc, (int)(cbu + i * 16384 + 16), 0)); }
#pragma unroll
                  for (int i = 0; i < 8; ++i) *(LAS v4u*)(Vimg + off128(srow + 4 * i, sch)) = pack8(t0[i], t1[i]); }
                LGW0();
            } else {
                if (sample) VMW(0); else VMW(8);
            }
            SCHEDB();
            bf16x8 kf[8];
#pragma unroll
            for (int ks = 0; ks < 8; ++ks) kf[ks] = *(const LAS bf16x8*)(Kimg + off128(j, 2 * ks + h));
            f32x16 s;
#pragma unroll
            for (int r = 0; r < 16; ++r) s[r] = 0.f;
#pragma unroll
            for (int ks = 0; ks < 8; ++ks) s = MFMA32(kf[ks], qf[ks], s);
            if (!sample && kt > 0) { LGW0(); SCHEDB(); dma_tile128(Kimg, kvb + (size_t)(kt - 1) * 262144, voff); SCHEDB(); }
            bf16x8 p0, p1;
            sb_tile_weights(s, lane, diag, later, p0, p1);
            if (!sample) { if (kt > 0) VMW(8); else VMW(0); }
            SCHEDB();
            sb_tile_pv(Vimg, lane, p0, p1, o);
            if (__all(later < SB_CUT2)) break;
            if (!sample && kt > 0) { LGW0(); SCHEDB(); dma_tile128(Vimg, kvb + (size_t)(kt - 1) * 262144 + 2048, voff); SCHEDB(); }
        }
        VMW(0); LGW0(); SCHEDB();
        dma_tile128(Kimg, qb + 6144, voff);
        VMW(0); SCHEDB();
#pragma unroll
        for (int c = 0; c < 4; ++c)
#pragma unroll
            for (int g = 0; g < 4; ++g) { const unsigned a = off128(j, 4 * c + g) + 8 * h; const u32x2v gv = *(const LAS u32x2v*)(Kimg + a);
                u32x2v ov; ov.x = cvtpk(o[c][4 * g] * silu_fast(bflo(gv.x)), o[c][4 * g + 1] * silu_fast(bfhi(gv.x))); ov.y = cvtpk(o[c][4 * g + 2] * silu_fast(bflo(gv.y)), o[c][4 * g + 3] * silu_fast(bfhi(gv.y)));
                *(LAS u32x2v*)(Vimg + a) = ov; }
        LGW0();
        { const unsigned ob = ((unsigned)m0 * 1024u + (unsigned)hh * 128u) * 2u;
#pragma unroll
          for (int i = 0; i < 8; ++i) { const v4u x = *(const LAS v4u*)(Vimg + off128(srow + 4 * i, sch)); __builtin_amdgcn_raw_buffer_store_b128(x, rsO, (int)vso, (int)(ob + i * 8192), 0); } }
    }
}
__device__ __forceinline__ void sb_attn_mfma(Frame& F, const bf16* PROJ, const float* cache_k, const float* cache_v, bf16* AO, int ctr_word) {
    if (F.G == 256) {
        LAS unsigned* ctr = (LAS unsigned*)(F.lds + MISC_OFF) + ctr_word;
        for (;;) {
            int it = 0; if (F.lane == 0) it = (int)__hip_atomic_fetch_add(ctr, 1u, __ATOMIC_RELAXED, __HIP_MEMORY_SCOPE_WORKGROUP);
            it = __builtin_amdgcn_readfirstlane(it);
            if (it > 32) break;
            if (it == 0) { const int b = F.vcu >> 3, hh = F.vcu & 7; sb_item<true>(F, PROJ, cache_k, cache_v, AO, b, hh, 64, (size_t)MP + b * 32); }
            else { const int bh = ((F.vcu >> 4) + (it - 1)) & 15, qt = (32 - it) * 16 + (F.vcu & 15);
                sb_item<false>(F, PROJ, cache_k, cache_v, AO, bh >> 3, bh & 7, qt, (size_t)(bh >> 3) * SEQ + 32 * qt); }
        }
    } else {
        const int gw = F.vcu * NWAVES + F.wave, NGW = F.G * NWAVES;
        for (int item = gw; item < 256; item += NGW) { const int b = item >> 3, hh = item & 7; sb_item<true>(F, PROJ, cache_k, cache_v, AO, b, hh, 64, (size_t)MP + b * 32); }
        for (int item = gw; item < 2 * 8 * 512; item += NGW) { const int qt = item & 511, bh = item >> 9; sb_item<false>(F, PROJ, cache_k, cache_v, AO, bh >> 3, bh & 7, qt, (size_t)(bh >> 3) * SEQ + 32 * qt); }
    }
}

__device__ __forceinline__ void swa_tile(const LAS unsigned char* Kimg, const LAS unsigned char* Vimg, int kt, bool sample, float slope2, const float (&cr)[16], int lane,
                                         const bf16x8 (&qf)[2][4], f32x16 (&o)[2][2], float (&mrun)[2], float (&lsum)[2]) {
    const int j = lane & 31, h = lane >> 5, blk = (lane >> 4) & 1, q4 = (lane & 15) >> 2, p4 = lane & 3;
    bf16x8 kf[4];
#pragma unroll
    for (int ks = 0; ks < 4; ++ks) kf[ks] = *(const LAS bf16x8*)(Kimg + off64(j, 2 * ks + h));
    bf16x8 vf[2][2];
#pragma unroll
    for (int c = 0; c < 2; ++c)
#pragma unroll
        for (int k2 = 0; k2 < 2; ++k2) { const unsigned a0 = off64(16 * k2 + 4 * h + q4, 4 * c + 2 * blk + (p4 >> 1)) + 8 * (p4 & 1), a1 = off64(16 * k2 + 8 + 4 * h + q4, 4 * c + 2 * blk + (p4 >> 1)) + 8 * (p4 & 1);
            vf[c][k2] = vtr2(Vimg + a0, Vimg + a1); }
    const float A0 = -slope2 * (float)(128 + j - 32 * kt - 4 * h), A1 = sample ? A0 : A0 - 32.0f * slope2;
    f32x16 s0, s1;
#pragma unroll
    for (int r = 0; r < 16; ++r) { const float t0 = A0 + cr[r], t1 = A1 + cr[r]; s0[r] = fminf(t0, -t0); s1[r] = fminf(t1, -t1); }
#pragma unroll
    for (int ks = 0; ks < 4; ++ks) { s0 = MFMA32(kf[ks], qf[0][ks], s0); s1 = MFMA32(kf[ks], qf[1][ks], s1); }
    float mx0 = fmaxf(fmaxf(fmaxf(s0[0], s0[1]), fmaxf(s0[2], s0[3])), fmaxf(fmaxf(s0[4], s0[5]), fmaxf(s0[6], s0[7])));
    float mx1 = fmaxf(fmaxf(fmaxf(s1[0], s1[1]), fmaxf(s1[2], s1[3])), fmaxf(fmaxf(s1[4], s1[5]), fmaxf(s1[6], s1[7])));
    mx0 = fmaxf(mx0, fmaxf(fmaxf(fmaxf(s0[8], s0[9]), fmaxf(s0[10], s0[11])), fmaxf(fmaxf(s0[12], s0[13]), fmaxf(s0[14], s0[15]))));
    mx1 = fmaxf(mx1, fmaxf(fmaxf(fmaxf(s1[8], s1[9]), fmaxf(s1[10], s1[11])), fmaxf(fmaxf(s1[12], s1[13]), fmaxf(s1[14], s1[15]))));
    mx0 = fmaxf(mx0, __shfl_xor(mx0, 32)); mx1 = fmaxf(mx1, __shfl_xor(mx1, 32));
    if (__any((mx0 > mrun[0]) || (mx1 > mrun[1]))) {
        const float n0 = fmaxf(mrun[0], mx0), n1 = fmaxf(mrun[1], mx1), f0 = __builtin_amdgcn_exp2f(mrun[0] - n0), f1 = __builtin_amdgcn_exp2f(mrun[1] - n1);
        mrun[0] = n0; mrun[1] = n1; lsum[0] *= f0; lsum[1] *= f1;
#pragma unroll
        for (int c = 0; c < 2; ++c)
#pragma unroll
            for (int r = 0; r < 16; ++r) { o[0][c][r] *= f0; o[1][c][r] *= f1; }
    }
    const float m0 = mrun[0], m1 = mrun[1];
    float ps0 = 0.f, ps1 = 0.f; unsigned pw0[8], pw1[8];
#pragma unroll
    for (int g = 0; g < 8; ++g) { const float e0 = __builtin_amdgcn_exp2f(s0[2 * g] - m0), e1 = __builtin_amdgcn_exp2f(s0[2 * g + 1] - m0), e2 = __builtin_amdgcn_exp2f(s1[2 * g] - m1), e3 = __builtin_amdgcn_exp2f(s1[2 * g + 1] - m1);
        ps0 += e0 + e1; ps1 += e2 + e3; pw0[g] = cvtpk(e0, e1); pw1[g] = cvtpk(e2, e3); }
    lsum[0] += ps0; lsum[1] += ps1;
    const bf16x8 p00 = __builtin_bit_cast(bf16x8, (v4u){pw0[0], pw0[1], pw0[2], pw0[3]}), p01 = __builtin_bit_cast(bf16x8, (v4u){pw0[4], pw0[5], pw0[6], pw0[7]});
    const bf16x8 p10 = __builtin_bit_cast(bf16x8, (v4u){pw1[0], pw1[1], pw1[2], pw1[3]}), p11 = __builtin_bit_cast(bf16x8, (v4u){pw1[4], pw1[5], pw1[6], pw1[7]});
#pragma unroll
    for (int c = 0; c < 2; ++c) { o[0][c] = MFMA32(vf[c][0], p00, o[0][c]); o[1][c] = MFMA32(vf[c][0], p10, o[1][c]); o[0][c] = MFMA32(vf[c][1], p01, o[0][c]); o[1][c] = MFMA32(vf[c][1], p11, o[1][c]); }
}
__device__ __forceinline__ void dma_tile64(LAS unsigned char* img, const char* tilebase, const unsigned (&voff)[2]) {
#pragma unroll
    for (int i = 0; i < 4; ++i) glds16s(tilebase + (size_t)i * 73728, voff[i & 1], (unsigned)(size_t)(img + i * 1024));
}
template <bool sample>
__device__ __forceinline__ void swa_attn_mfma_t(Frame& F, const bf16* PROJ, const float* cache_k, const float* cache_v, const float* sinks, bf16* AO) {
    LAS unsigned char* buf = F.lds + RING_OFF + F.wave * 16384;
    const int lane = F.lane, j = lane & 31, h = lane >> 5;
    const int gw = F.vcu * NWAVES + F.wave, NGW = F.G * NWAVES;
    const int srow = lane >> 3, sch = lane & 7;
    unsigned voff[2];
#pragma unroll
    for (int v = 0; v < 2; ++v) voff[v] = (unsigned)srow * 9216u + (unsigned)(sch ^ ((((srow >> 1) & 1) << 2) | ((2 * v + (srow >> 2)) & 3))) * 16u;
    const rsrc_t rsO = mk_rsrc(AO);
    const unsigned vso = (unsigned)(srow * 2048 + sch * 8) * 2u;
    constexpr int NPI = 2 * 256 * 4 * 8;
    for (int item = gw; item < (sample ? 1024 : NPI); item += NGW) {
        int b, c64, kvh, rr; size_t m0; int kt_lo;
        if (!sample) { rr = item & 7; kvh = (item >> 3) & 3; c64 = (item >> 5) & 255; b = item >> 13; m0 = (size_t)b * SEQ + 64 * c64; kt_lo = (c64 >= 2) ? 0 : (4 - 2 * c64); }
        else { rr = item & 7; kvh = (item >> 3) & 3; b = item >> 5; c64 = 0; m0 = (size_t)MP + b * 32; kt_lo = 0; }
        const int hq = kvh * 8 + rr;
        const float slope2 = exp2f(-0.25f * (float)(hq + 1)) * 1.4426950408889634f;
        const float sink = sinks[hq] * 1.4426950408889634f;
        float cr[16];
#pragma unroll
        for (int r = 0; r < 16; ++r) cr[r] = slope2 * (float)((r & 3) + 8 * (r >> 2));
        const char* qb = (const char*)(PROJ + m0 * 4608 + hq * 64);
        LGW0();
        dma_tile64(buf + 8192, qb, voff); dma_tile64(buf + 12288, qb + (sample ? 0 : 294912), voff);
        VMW(0);
        bf16x8 qf[2][4];
#pragma unroll
        for (int qi = 0; qi < 2; ++qi)
#pragma unroll
            for (int ks = 0; ks < 4; ++ks) qf[qi][ks] = *(const LAS bf16x8*)(buf + 8192 + 4096 * qi + off64(j, 2 * ks + h));
        LGW0(); SCHEDB();
        f32x16 o[2][2];
#pragma unroll
        for (int qi = 0; qi < 2; ++qi)
#pragma unroll
            for (int c = 0; c < 2; ++c)
#pragma unroll
                for (int r = 0; r < 16; ++r) o[qi][c][r] = 0.f;
        float mrun[2] = {sink, sink}, lsum[2] = {h == 0 ? 1.f : 0.f, h == 0 ? 1.f : 0.f};
        if (!sample) {
            const char* kvb = (const char*)(PROJ + ((size_t)b * SEQ + 64 * (size_t)c64) * 4608 + 2048 + kvh * 64) - (size_t)128 * 9216;
            LGW0();
            dma_tile64(buf, kvb + (size_t)5 * 294912, voff); dma_tile64(buf + 4096, kvb + (size_t)5 * 294912 + 512, voff);
            for (int kt = 5; kt >= kt_lo; --kt) {
                LAS unsigned char* cur = buf + (((5 - kt) & 1) ? 8192 : 0); LAS unsigned char* nxt = buf + (((5 - kt) & 1) ? 0 : 8192);
                if (kt > kt_lo) { LGW0(); SCHEDB(); dma_tile64(nxt, kvb + (size_t)(kt - 1) * 294912, voff); dma_tile64(nxt + 4096, kvb + (size_t)(kt - 1) * 294912 + 512, voff); VMW(8); }
                else VMW(0);
                SCHEDB();
                swa_tile(cur, cur + 4096, kt, false, slope2, cr, lane, qf, o, mrun, lsum);
            }
        } else {
            LAS unsigned char* Kimg = buf; LAS unsigned char* Vimg = buf + 4096;
            for (int kt = 0; kt < 5; ++kt) {
                LGW0();
                if (kt == 4) { const char* kb = (const char*)(PROJ + m0 * 4608 + 2048 + kvh * 64); dma_tile64(Kimg, kb, voff); dma_tile64(Vimg, kb + 512, voff); VMW(0); }
                else {
                    const size_t cb = (((size_t)b * 128 + 32 * kt + srow) * 4 + kvh) * 64 + sch * 8;
#pragma unroll
                    for (int i = 0; i < 4; ++i) { const size_t o8 = cb + (size_t)(8 * i) * 256; const unsigned a = off64(srow + 8 * i, sch);
                        const f32x4 k0 = *(const GAS f32x4*)(cache_k + o8), k1 = *(const GAS f32x4*)(cache_k + o8 + 4), v0 = *(const GAS f32x4*)(cache_v + o8), v1 = *(const GAS f32x4*)(cache_v + o8 + 4);
                        *(LAS v4u*)(Kimg + a) = pack8(k0, k1); *(LAS v4u*)(Vimg + a) = pack8(v0, v1); }
                    LGW0();
                }
                SCHEDB();
                swa_tile(Kimg, Vimg, kt, true, slope2, cr, lane, qf, o, mrun, lsum);
            }
        }
        VMW(0); LGW0(); SCHEDB();
        dma_tile64(buf, qb + 5120, voff); dma_tile64(buf + 4096, qb + 5120 + (sample ? 0 : 294912), voff);
        VMW(0); SCHEDB();
#pragma unroll
        for (int qi = 0; qi < 2; ++qi) {
            const float inv = 1.0f / (lsum[qi] + __shfl_xor(lsum[qi], 32));
#pragma unroll
            for (int c = 0; c < 2; ++c)
#pragma unroll
                for (int g = 0; g < 4; ++g) { const unsigned a = 4096 * qi + off64(j, 4 * c + g) + 8 * h; const u32x2v gv = *(const LAS u32x2v*)(buf + a);
                    u32x2v ov; ov.x = cvtpk(o[qi][c][4 * g] * inv * silu_fast(bflo(gv.x)), o[qi][c][4 * g + 1] * inv * silu_fast(bfhi(gv.x))); ov.y = cvtpk(o[qi][c][4 * g + 2] * inv * silu_fast(bflo(gv.y)), o[qi][c][4 * g + 3] * inv * silu_fast(bfhi(gv.y)));
                    *(LAS u32x2v*)(buf + 8192 + a) = ov; }
        }
        LGW0();
        { const unsigned ob = ((unsigned)m0 * 2048u + (unsigned)hq * 64u) * 2u;
#pragma unroll
          for (int qi = 0; qi < 2; ++qi) {
              if (sample && qi == 1) break;
#pragma unroll
              for (int i = 0; i < 4; ++i) { const v4u x = *(const LAS v4u*)(buf + 8192 + 4096 * qi + off64(srow + 8 * i, sch)); __builtin_amdgcn_raw_buffer_store_b128(x, rsO, (int)vso, (int)(ob + qi * 131072 + i * 32768), 0); } } }
    }
}
#define WG_BAR() asm volatile("s_waitcnt vmcnt(0) lgkmcnt(0)\n\ts_barrier" ::: "memory")
__device__ __forceinline__ void swa_attn_wg(Frame& F, const bf16* PROJ, const float* cache_k, const float* cache_v, const float* sinks, bf16* AO) {
    LAS unsigned char* KV = F.lds + RING_OFF;
    LAS unsigned char* stg = F.lds + RING_OFF + 49152 + F.wave * 8192;
    const int lane = F.lane, j = lane & 31, h = lane >> 5;
    const int srow = lane >> 3, sch = lane & 7;
    unsigned voff[2];
#pragma unroll
    for (int v = 0; v < 2; ++v) voff[v] = (unsigned)srow * 9216u + (unsigned)(sch ^ ((((srow >> 1) & 1) << 2) | ((2 * v + (srow >> 2)) & 3))) * 16u;
    const rsrc_t rsO = mk_rsrc(AO);
    const unsigned vso = (unsigned)(srow * 2048 + sch * 8) * 2u;
    constexpr int NPU = 2 * 256 * 4, NU = NPU + 32 * 4;
    auto fill = [&](int u) {
        if (u < NPU) { const int kvh = u & 3, c64 = (u >> 2) & 255, b = u >> 10, kt_lo = (c64 >= 2) ? 0 : (4 - 2 * c64);
            const char* kvb = (const char*)(PROJ + ((size_t)b * SEQ + 64 * (size_t)c64) * 4608 + 2048 + kvh * 64) - (size_t)128 * 9216;
#pragma unroll
            for (int i = 0; i < 6; ++i) { const int p = F.wave * 6 + i, kt = p >> 3, w8 = p & 7;
                if (kt >= kt_lo) glds16s(kvb + (size_t)kt * 294912 + (w8 >> 2) * 512 + (size_t)(w8 & 3) * 73728, voff[w8 & 1], (unsigned)(size_t)(KV + kt * 8192 + (w8 >> 2) * 4096 + (w8 & 3) * 1024)); }
        } else { const int su = u - NPU, kvh = su & 3, b = su >> 2;
            if (F.wave < 2) { const char* kb = (const char*)(PROJ + ((size_t)MP + b * 32) * 4608 + 2048 + kvh * 64) + F.wave * 512;
#pragma unroll
                for (int i = 0; i < 4; ++i) glds16s(kb + (size_t)i * 73728, voff[i & 1], (unsigned)(size_t)(KV + 4 * 8192 + F.wave * 4096 + i * 1024)); }
#pragma unroll
            for (int i = 0; i < 4; ++i) { const int ci = F.tid + 512 * i, kvsel = ci >> 10, cc = ci & 1023, kt = cc >> 8, row = (cc >> 3) & 31, ch = cc & 7;
                const float* src = (kvsel ? cache_v : cache_k) + (((size_t)b * 128 + 32 * kt + row) * 4 + kvh) * 64 + ch * 8;
                const f32x4 x0 = *(const GAS f32x4*)src, x1 = *(const GAS f32x4*)(src + 4);
                *(LAS v4u*)(KV + kt * 8192 + kvsel * 4096 + off64(row, ch)) = pack8(x0, x1); }
        }
    };
    auto qfill = [&](int u) {
        size_t m0; int hq; bool sample = u >= NPU;
        if (!sample) { const int kvh = u & 3, c64 = (u >> 2) & 255, b = u >> 10; m0 = (size_t)b * SEQ + 64 * c64; hq = kvh * 8 + F.wave; }
        else { const int su = u - NPU, kvh = su & 3, b = su >> 2; m0 = (size_t)MP + b * 32; hq = kvh * 8 + F.wave; }
        const char* qb = (const char*)(PROJ + m0 * 4608 + hq * 64);
        dma_tile64(stg, qb, voff); dma_tile64(stg + 4096, qb + (sample ? 0 : 294912), voff);
    };
    int u = F.vcu;
    if (u < NU) { fill(u); qfill(u); }
    for (; u < NU; u += F.G) {
        const bool sample = u >= NPU;
        int kvh, c64, b; size_t m0; int kt_lo, kt_hi;
        if (!sample) { kvh = u & 3; c64 = (u >> 2) & 255; b = u >> 10; m0 = (size_t)b * SEQ + 64 * c64; kt_lo = (c64 >= 2) ? 0 : (4 - 2 * c64); kt_hi = 5; }
        else { const int su = u - NPU; kvh = su & 3; b = su >> 2; c64 = 0; m0 = (size_t)MP + b * 32; kt_lo = 0; kt_hi = 4; }
        const int hq = kvh * 8 + F.wave;
        const float slope2 = exp2f(-0.25f * (float)(hq + 1)) * 1.4426950408889634f;
        const float sink = sinks[hq] * 1.4426950408889634f;
        float cr[16];
#pragma unroll
        for (int r = 0; r < 16; ++r) cr[r] = slope2 * (float)((r & 3) + 8 * (r >> 2));
        WG_BAR();
        bf16x8 qf[2][4];
#pragma unroll
        for (int qi = 0; qi < 2; ++qi)
#pragma unroll
            for (int ks = 0; ks < 4; ++ks) qf[qi][ks] = *(const LAS bf16x8*)(stg + 4096 * qi + off64(j, 2 * ks + h));
        f32x16 o[2][2];
#pragma unroll
        for (int qi = 0; qi < 2; ++qi)
#pragma unroll
            for (int c = 0; c < 2; ++c)
#pragma unroll
                for (int r = 0; r < 16; ++r) o[qi][c][r] = 0.f;
        float mrun[2] = {sink, sink}, lsum[2] = {h == 0 ? 1.f : 0.f, h == 0 ? 1.f : 0.f};
        for (int kt = kt_hi; kt >= kt_lo; --kt) swa_tile(KV + kt * 8192, KV + kt * 8192 + 4096, kt, sample, slope2, cr, lane, qf, o, mrun, lsum);
        WG_BAR();
        const int un = u + F.G;
        if (un < NU) fill(un);
        { const char* qb = (const char*)(PROJ + m0 * 4608 + hq * 64);
          dma_tile64(stg, qb + 5120, voff); dma_tile64(stg + 4096, qb + 5120 + (sample ? 0 : 294912), voff); }
        VMW(0); SCHEDB();
#pragma unroll
        for (int qi = 0; qi < 2; ++qi) {
            const float inv = 1.0f / (lsum[qi] + __shfl_xor(lsum[qi], 32));
#pragma unroll
            for (int c = 0; c < 2; ++c)
#pragma unroll
                for (int g = 0; g < 4; ++g) { const unsigned a = 4096 * qi + off64(j, 4 * c + g) + 8 * h; const u32x2v gv = *(const LAS u32x2v*)(stg + a);
                    u32x2v ov; ov.x = cvtpk(o[qi][c][4 * g] * inv * silu_fast(bflo(gv.x)), o[qi][c][4 * g + 1] * inv * silu_fast(bfhi(gv.x))); ov.y = cvtpk(o[qi][c][4 * g + 2] * inv * silu_fast(bflo(gv.y)), o[qi][c][4 * g + 3] * inv * silu_fast(bfhi(gv.y)));
                    *(LAS u32x2v*)(stg + a) = ov; }
        }
        LGW0();
        { const unsigned ob = ((unsigned)m0 * 2048u + (unsigned)hq * 64u) * 2u;
#pragma unroll
          for (int qi = 0; qi < 2; ++qi) {
              if (sample && qi == 1) break;
#pragma unroll
              for (int i = 0; i < 4; ++i) { const v4u x = *(const LAS v4u*)(stg + 4096 * qi + off64(srow + 8 * i, sch)); __builtin_amdgcn_raw_buffer_store_b128(x, rsO, (int)vso, (int)(ob + qi * 131072 + i * 32768), 0); } } }
        LGW0();
        if (un < NU) qfill(un);
    }
    WG_BAR();
}
__device__ __forceinline__ void swa_attn_mfma(Frame& F, const bf16* PROJ, const float* cache_k, const float* cache_v, const float* sinks, bf16* AO) {
    swa_attn_wg(F, PROJ, cache_k, cache_v, sinks, AO);
}

template <bool FULL>
__device__ __forceinline__ void s5_unit_mfma(Frame& F, const Ptrs& P, const bf16* PROJ, bf16* Y1, size_t row0, int NT, int g, float& hr, float& hi,
                                             const bf16x8 (&bfr)[4], const bf16x8 (&cfr)[8], float lr, float li, const f32x4 (&dd)[2]) {
    LAS unsigned char* img = F.lds + RING_OFF + F.wave * 16384;
    const int lane = F.lane, j = lane & 31, h = lane >> 5;
    bf16x8 ufn = *(const GAS bf16x8*)(PROJ + (row0 + j) * 2048 + g * 16 + 8 * h);
    for (int mt = 0; mt < NT; ++mt) {
        const bf16x8 uf = ufn;
        if (mt + 1 < NT) ufn = *(const GAS bf16x8*)(PROJ + (row0 + 32 * (mt + 1) + j) * 2048 + g * 16 + 8 * h);
        f32x16 z16;
#pragma unroll
        for (int r = 0; r < 16; ++r) z16[r] = 0.f;
        LGW0();
#pragma unroll
        for (int pt = 0; pt < 4; ++pt) { const f32x16 bu = MFMA32(uf, bfr[pt], z16);
#pragma unroll
            for (int r = 0; r < 16; ++r) { const int t = (r & 3) + 8 * (r >> 2) + 4 * h; *(LAS float*)(img + 512 * t + 4 * (32 * pt + j)) = bu[r]; } }
        LGW0();
#pragma unroll
        for (int t = 0; t < 32; ++t) {
            const float bur = *(const LAS float*)(img + 512 * t + 4 * lane), bui = *(const LAS float*)(img + 512 * t + 256 + 4 * lane);
            const float nr = lr * hr - li * hi + bur, ni = lr * hi + li * hr + bui; hr = nr; hi = ni;
            if (FULL) { const unsigned a0 = 512 * t + 16 * ((lane >> 3) ^ (t & 15)) + 2 * (lane & 7), a1 = 512 * t + 16 * ((8 + (lane >> 3)) ^ (t & 15)) + 2 * (lane & 7);
                *(LAS unsigned short*)(img + a0) = (unsigned short)f2bf(hr); *(LAS unsigned short*)(img + a1) = (unsigned short)f2bf(hi); }
        }
        if (FULL) {
            LGW0();
            f32x16 y = z16;
#pragma unroll
            for (int ks = 0; ks < 8; ++ks) { const bf16x8 hf = *(const LAS bf16x8*)(img + 512 * j + 16 * ((2 * ks + h) ^ (j & 15))); y = MFMA32(hf, cfr[ks], y); }
#pragma unroll
            for (int r = 0; r < 16; ++r) { const int t = (r & 3) + 8 * (r >> 2) + 4 * h; *(LAS float*)(img + 512 * t + 256 + 4 * j) = y[r]; }
            LGW0();
            const f32x4 y0 = *(const LAS f32x4*)(img + 512 * j + 256 + 32 * h), y1 = *(const LAS f32x4*)(img + 512 * j + 256 + 32 * h + 16);
            const v4u uw = __builtin_bit_cast(v4u, uf);
            f32x4 r0, r1;
            r0.x = gelu_tanh_f(y0.x + dd[0].x * bflo(uw.x)); r0.y = gelu_tanh_f(y0.y + dd[0].y * bfhi(uw.x)); r0.z = gelu_tanh_f(y0.z + dd[0].z * bflo(uw.y)); r0.w = gelu_tanh_f(y0.w + dd[0].w * bfhi(uw.y));
            r1.x = gelu_tanh_f(y1.x + dd[1].x * bflo(uw.z)); r1.y = gelu_tanh_f(y1.y + dd[1].y * bfhi(uw.z)); r1.z = gelu_tanh_f(y1.z + dd[1].z * bflo(uw.w)); r1.w = gelu_tanh_f(y1.w + dd[1].w * bfhi(uw.w));
            *(GAS v4u*)(Y1 + (row0 + 32 * mt + j) * 1024 + g * 16 + 8 * h) = pack8(r0, r1);
        }
    }
}
struct S5Consts { bf16x8 bfr[4]; bf16x8 cfr[8]; float lr, li; f32x4 dd[2]; };
template <bool FULL>
__device__ __forceinline__ void s5_load_consts(Frame& F, const Ptrs& P, int g, bf16x8 (&bfr)[4], bf16x8 (&cfr)[8], float& lr, float& li, f32x4 (&dd)[2]) {
    const int lane = F.lane, j = lane & 31, h = lane >> 5;
    const bf16* BBb = (const bf16*)(P.ws + WS_BBB); const bf16* Cmb = (const bf16*)(P.ws + WS_CMB);
    const float* lam = (const float*)(P.ws + WS_SSMC);
#pragma unroll
    for (int pt = 0; pt < 4; ++pt) bfr[pt] = *(const GAS bf16x8*)(BBb + ((size_t)g * 128 + 32 * pt + j) * 16 + 8 * h);
    lr = lam[2 * (g * 64 + lane)]; li = lam[2 * (g * 64 + lane) + 1];
    if (FULL) {
        const bf16x8 zero8 = {0, 0, 0, 0, 0, 0, 0, 0};
#pragma unroll
        for (int ks = 0; ks < 8; ++ks) { const bf16x8 v = *(const GAS bf16x8*)(Cmb + ((size_t)g * 16 + (j & 15)) * 128 + 16 * ks + 8 * h); cfr[ks] = (j < 16) ? v : zero8; }
        dd[0] = *(const GAS f32x4*)(P.in[23] + g * 16 + 8 * h); dd[1] = *(const GAS f32x4*)(P.in[23] + g * 16 + 8 * h + 4);
    }
}
__device__ __forceinline__ void s5_local_mfma(Frame& F, const Ptrs& P, const bf16* PROJ) {
    float* SEND = (float*)(P.ws + WS_SEND);
    for (int vw = F.vcu * NWAVES + F.wave; vw < 2048; vw += F.G * NWAVES) {
        const int g = vw & 63, seg = vw >> 6;
        bf16x8 bfr[4], cfr[8]; float lr, li; f32x4 dd[2];
        s5_load_consts<false>(F, P, g, bfr, cfr, lr, li, dd);
        float hr = 0.f, hi = 0.f;
        s5_unit_mfma<false>(F, P, PROJ, nullptr, (size_t)seg * 1024, 32, g, hr, hi, bfr, cfr, lr, li, dd);
        SEND[((size_t)seg * 64 + g) * 128 + F.lane] = hr; SEND[((size_t)seg * 64 + g) * 128 + 64 + F.lane] = hi;
    }
}
__device__ __forceinline__ void s5_carry_seg(Frame& F, const Ptrs& P) {
    for (int gt = F.vcu * (NWAVES * 64) + F.tid; gt < 2 * 64 * 64; gt += F.G * NWAVES * 64) {
    const int b = gt >> 12, gp = gt & 4095, g = gp >> 6, p = gp & 63;
    const float* SEND = (const float*)(P.ws + WS_SEND); float* HIN = (float*)(P.ws + WS_HIN);
    const float* lam64 = (const float*)(P.ws + WS_SSMC) + 64 * 64 * 2;
    float lr = lam64[2 * gp], li = lam64[2 * gp + 1];
#pragma unroll
    for (int i = 0; i < 4; ++i) { const float nr = lr * lr - li * li, ni = 2.0f * lr * li; lr = nr; li = ni; }
    float sr[16], si[16];
#pragma unroll
    for (int s = 0; s < 16; ++s) { const size_t o = (((size_t)b * 16 + s) * 64 + g) * 128 + p; sr[s] = SEND[o]; si[s] = SEND[o + 64]; }
    float hr = 0.f, hi = 0.f;
#pragma unroll
    for (int s = 0; s < 16; ++s) { const size_t o = (((size_t)b * 16 + s) * 64 + g) * 128 + p; HIN[o] = hr; HIN[o + 64] = hi;
        const float nr = lr * hr - li * hi + sr[s], ni = lr * hi + li * hr + si[s]; hr = nr; hi = ni; }
    P.out[O_HRP + (size_t)b * 4096 + gp] = hr; P.out[O_HIP + (size_t)b * 4096 + gp] = hi;
    }
}
__device__ __forceinline__ void s5_full_mfma(Frame& F, const Ptrs& P, const bf16* PROJ, bf16* Y1) {
    const float* HIN = (const float*)(P.ws + WS_HIN);
    for (int vw = F.vcu * NWAVES + F.wave; vw < 2048; vw += F.G * NWAVES) {
    const int g = vw & 63, seg = vw >> 6;
    bf16x8 bfr[4], cfr[8]; float lr, li; f32x4 dd[2];
    s5_load_consts<true>(F, P, g, bfr, cfr, lr, li, dd);
    { float hr = HIN[((size_t)seg * 64 + g) * 128 + F.lane], hi = HIN[((size_t)seg * 64 + g) * 128 + 64 + F.lane];
      s5_unit_mfma<true>(F, P, PROJ, Y1, (size_t)seg * 1024, 32, g, hr, hi, bfr, cfr, lr, li, dd); }
    { const int b = seg;
      float hr = P.in[6][((size_t)b * 64 + g) * 64 + F.lane], hi = P.in[7][((size_t)b * 64 + g) * 64 + F.lane];
      s5_unit_mfma<true>(F, P, PROJ, Y1, (size_t)MP + b * 32, 1, g, hr, hi, bfr, cfr, lr, li, dd);
      P.out[O_HRS + ((size_t)b * 64 + g) * 64 + F.lane] = hr; P.out[O_HIS + ((size_t)b * 64 + g) * 64 + F.lane] = hi; }
    }
}
constexpr int N_PHASES = 20;
#ifndef MK_PER_PHASE
#define MK_PER_PHASE 0
#endif
#ifndef GEMM_SP2
#define GEMM_SP2 true
#endif
#ifndef ALIGNE
#define ALIGNE true
#endif
constexpr int CW_FLOW = 8192;
template <class Epi>
__device__ __forceinline__ void gemm_parts(Frame& F, XcdBarrier& bar, const pg8::Gemm& g, const Epi& E, int N, int bx, int rot, bool midbar, unsigned* wset, unsigned wneed, unsigned* sset) {
    for (int part = 0; part < 2; ++part) {
        pg8::StaticOrder S;
        if (part == 0) S.init_part(NPM_P, 0, N, F.G, bx); else S.init_part(NPM - NPM_P, NPM_P, N, F.G, (bx + F.G - rot % F.G) % F.G);
        if (part == 1 && midbar) xcd_barrier(bar);
        pg8::Unit u0; if (!S.next(0, u0)) continue;
        if (part == 1 && wset) {
            if (F.tid == 0) { unsigned sp = 0;
                while (__hip_atomic_load(wset, __ATOMIC_RELAXED, __HIP_MEMORY_SCOPE_AGENT) < wneed) { __builtin_amdgcn_s_sleep(2); if (++sp > (1u << 22)) break; }
                __builtin_amdgcn_fence(__ATOMIC_ACQUIRE, "agent"); }
            __syncthreads();
        }
#ifdef DELAY_SAMPLE
        if (part == 1 && sset) { const unsigned long long ti = __builtin_amdgcn_s_memrealtime(); while (__builtin_amdgcn_s_memrealtime() - ti < (unsigned long long)(DELAY_SAMPLE) * 100ull) __builtin_amdgcn_s_sleep(32); }
#endif
        pg8::gemm_phase<Epi, pg8::StaticOrder, ALIGNE, GEMM_SP2>(F.lds + RING_OFF, g, S, E);
        if (part == 1 && sset && F.tid == 0) { __threadfence(); unsigned n = 0; pg8::Unit u; for (int i = 0; S.next(i, u); ++i) ++n; __hip_atomic_fetch_add(sset, n, __ATOMIC_RELAXED, __HIP_MEMORY_SCOPE_AGENT); }
    }
}
__global__ void __launch_bounds__(NWAVES * 64, 2) enc_fwd(Ptrs P) {
    extern __shared__ __attribute__((aligned(16))) unsigned char lds[];
    Frame F;
    F.lds = (LAS unsigned char*)lds;
    F.MISC = (volatile LAS unsigned*)(F.lds + MISC_OFF);
    F.tid = threadIdx.x; F.lane = F.tid & 63; F.wave = __builtin_amdgcn_readfirstlane(F.tid >> 6);
    F.G = gridDim.x; { const int bx = blockIdx.x; F.vcu = (F.G % 8 == 0) ? (bx % 8) * (F.G / 8) + bx / 8 : bx; }
    unsigned char* ws = P.ws;
    F.ctl = (gu32*)(ws + WS_CTL);
    for (int u = F.tid; u < (LDS_BYTES - LDSCTL_OFF) / 4; u += NWAVES * 64) ((LAS unsigned*)(F.lds + LDSCTL_OFF))[u] = 0u;
    __syncthreads();
    XcdBarrier bar; bar.bar = (unsigned*)(F.ctl + CW_BAR); bar.x = 0; bar.st = nullptr;
    if (!MK_PER_PHASE) bar = xcd_barrier_post((unsigned*)(F.ctl + CW_BAR), F.MISC + 8);
    const int lo = P.ph_lo, hi = P.ph_hi;
#define IN(k) (lo <= (k) && (k) < hi)
#define SEAM(k) do { if (IN(k) && IN((k) + 1)) xcd_barrier(bar); } while (0)
#define PHASE(k) if (IN(k))
    float* const C1C2 = (float*)(ws + WS_C1C2); float* const ST = (float*)(ws + WS_STATS);
    bf16* const XB = (bf16*)(ws + WS_XB); float* const XF = (float*)(ws + WS_XF); bf16* const PROJ = (bf16*)(ws + WS_PROJ); bf16* const AO = (bf16*)(ws + WS_AO); bf16* const AOC = (bf16*)(ws + WS_AOC);
    const int bx = (int)blockIdx.x;
    unsigned* const FL = (unsigned*)(F.ctl + CW_FLOW);
    constexpr int NS = NPM - NPM_P;

    PHASE(0) { p0_prologue(F, P); } SEAM(0);
    PHASE(1) { pg8::Gemm g{XB, (const bf16*)(ws + WS_WINA0), M, 4096, 2048}; pg8::StaticOrder S; S.init(M, 4096, F.G, bx);
        pg8::EpiProjA<false> E{PROJ, P.out + O_KAP, P.out + O_VAP, P.out + O_KAS, P.out + O_VAS, pg8::RowAff{nullptr, nullptr, nullptr, nullptr}};
        pg8::gemm_phase<pg8::EpiProjA<false>, pg8::StaticOrder, ALIGNE, GEMM_SP2>(F.lds + RING_OFF, g, S, E);
        { const int nt = (NPM * 16) % F.G;
          if (nt > 0 && bx >= nt) { p0_weights(F, P, PW_R0, PW_R1, (bx - nt) * NWAVES + F.wave, (F.G - nt) * NWAVES); p0_s5tables(P, (bx - nt) * (NWAVES * 64) + F.tid, (F.G - nt) * (NWAVES * 64)); }
          else if (nt == 0) { p0_weights(F, P, PW_R0, PW_R1, bx * NWAVES + F.wave, F.G * NWAVES); p0_s5tables(P, bx * (NWAVES * 64) + F.tid, F.G * (NWAVES * 64)); } } } SEAM(1);
    PHASE(2) { sb_attn_mfma(F, PROJ, P.in[2], P.in[3], AO, 16); } SEAM(2);
    PHASE(3) { pg8::Gemm g{AO, (const bf16*)(ws + WS_WOUTA0), M, 2048, 1024};
        pg8::EpiResidB<false, false, true> E{XB, XB, nullptr, nullptr, nullptr, nullptr, nullptr, ST, ST + M};
        gemm_parts(F, bar, g, E, 2048, bx, 0, true, nullptr, 0u, FL); }
    PHASE(5) { pg8::Gemm g{XB, (const bf16*)(ws + WS_WINB), M, 4608, 2048};
        pg8::EpiProjB E{PROJ, P.out, pg8::RowAff{ST, ST + M, C1C2, C1C2 + 4608}};
        gemm_parts(F, bar, g, E, 4608, bx, NS * 8, false, FL, (unsigned)(NS * 8), nullptr);
        { const int c5 = (bx + F.G - (NS * 8) % F.G) % F.G, nt = NS * 18, nf = F.G - nt - NS * 8;
          if (nf > 0) { if (c5 >= nt && c5 < nt + nf) p0_weights(F, P, PW_R1, PW_R2, (c5 - nt) * NWAVES + F.wave, nf * NWAVES); }
          else p0_weights(F, P, PW_R1, PW_R2, bx * NWAVES + F.wave, F.G * NWAVES); } } SEAM(5);
    PHASE(6) { swa_attn_mfma(F, PROJ, P.in[4], P.in[5], P.in[13], AO); } SEAM(6);
    PHASE(7) { pg8::Gemm g{AO, (const bf16*)(ws + WS_WOUTB), M, 2048, 2048};
        pg8::EpiResidB<false, true, true> E{XB, XB, nullptr, ST, ST + M, P.in[8], P.in[9], ST + 2 * M, ST + 3 * M};
        gemm_parts(F, bar, g, E, 2048, bx, 0, true, nullptr, 0u, FL + 64); }
    PHASE(9) { pg8::Gemm g{XB, (const bf16*)(ws + WS_WINC), M, 2048, 2048};
        pg8::EpiProjC E{PROJ, pg8::RowAff{ST + 2 * M, ST + 3 * M, C1C2 + 2 * 4608, C1C2 + 3 * 4608}};
        gemm_parts(F, bar, g, E, 2048, bx, NS * 8, false, FL + 64, (unsigned)(NS * 8), nullptr); } SEAM(9);
    PHASE(10) { s5_local_mfma(F, P, PROJ); } SEAM(10);
    PHASE(11) { s5_carry_seg(F, P); } SEAM(11);
    PHASE(12) { s5_full_mfma(F, P, PROJ, AO); } SEAM(12);
    PHASE(13) { pg8::Gemm g{AO, (const bf16*)(ws + WS_WGLU), M, 1024, 1024};
        pg8::EpiGlu E{AO, PROJ, AOC};
        gemm_parts(F, bar, g, E, 1024, bx, 0, true, nullptr, 0u, FL + 128); }
    PHASE(14) { pg8::Gemm g{AOC, (const bf16*)(ws + WS_WOUTC), M, 2048, 1024};
        pg8::EpiResidB<false, true, true> E{XB, XB, nullptr, ST + 2 * M, ST + 3 * M, P.in[8] + DM, P.in[9] + DM, ST + 4 * M, ST + 5 * M};
        gemm_parts(F, bar, g, E, 2048, bx, NS * 4, true, FL + 128, (unsigned)(NS * 4), FL + 192); }
    PHASE(16) { pg8::Gemm g{XB, (const bf16*)(ws + WS_WINA1), M, 4096, 2048};
        pg8::EpiProjA<true> E{PROJ, P.out + O_KAP + (size_t)MP * 1024, P.out + O_VAP + (size_t)MP * 1024, P.out + O_KAS + (size_t)MS * 1024, P.out + O_VAS + (size_t)MS * 1024, pg8::RowAff{ST + 4 * M, ST + 5 * M, C1C2 + 4 * 4608, C1C2 + 5 * 4608}};
        gemm_parts(F, bar, g, E, 4096, bx, NS * 12, false, FL + 192, (unsigned)(NS * 8), nullptr); } SEAM(16);
    PHASE(17) { sb_attn_mfma(F, PROJ, P.in[2] + (size_t)DECB * PAST * 1024, P.in[3] + (size_t)DECB * PAST * 1024, AO, 17); } SEAM(17);
    PHASE(18) { pg8::Gemm g{AO, (const bf16*)(ws + WS_WOUTA1), M, 2048, 1024};
        pg8::EpiResidB<false, true, true> E{XB, XB, nullptr, ST + 4 * M, ST + 5 * M, P.in[8] + 2 * DM, P.in[9] + 2 * DM, ST + 6 * M, ST + 7 * M};
        gemm_parts(F, bar, g, E, 2048, bx, 0, true, nullptr, 0u, FL + 256); }
    PHASE(19) { const int nsu = NS * 8, nS = nsu < F.G ? nsu : 0;
        if (nS > 0 && bx >= nS) ln_phase_final(F, XB, ST + 6 * M, ST + 7 * M, P.out + O_YP, P.in[8] + 3 * DM, P.in[9] + 3 * DM, 0, MP, (bx - nS) * NWAVES + F.wave, (F.G - nS) * NWAVES);
        else {
            if (F.tid == 0) { unsigned sp = 0; while (__hip_atomic_load(FL + 256, __ATOMIC_RELAXED, __HIP_MEMORY_SCOPE_AGENT) < (unsigned)nsu) { __builtin_amdgcn_s_sleep(2); if (++sp > (1u << 22)) break; }
                __builtin_amdgcn_fence(__ATOMIC_ACQUIRE, "agent"); }
            __syncthreads();
            if (nS > 0) ln_phase_final(F, XB, ST + 6 * M, ST + 7 * M, P.out + O_YP, P.in[8] + 3 * DM, P.in[9] + 3 * DM, MP, M, bx * NWAVES + F.wave, nS * NWAVES);
            else ln_phase_final(F, XB, ST + 6 * M, ST + 7 * M, P.out + O_YP, P.in[8] + 3 * DM, P.in[9] + 3 * DM, 0, M, F.vcu * NWAVES + F.wave, F.G * NWAVES); } }
#undef IN
#undef SEAM
}

extern "C" void kernel_launch(void* const* d_in, const int* in_sizes, int n_in, void* d_out, int out_size, void* d_ws, size_t ws_size, hipStream_t stream) {
    static int grid = 0;
    if (grid == 0) {
        if (n_in != 26 || (size_t)out_size != O_END || ws_size < WS_END) { fprintf(stderr, "kernel_launch: unexpected shapes: n_in %d out %d (want %zu) ws %zu (want >= %zu); nothing launched\n", n_in, out_size, (size_t)O_END, ws_size, (size_t)WS_END); grid = -1; return; }
        int dev = 0, cus = 0, per_cu = 0;
        if (hipGetDevice(&dev) != hipSuccess || hipDeviceGetAttribute(&cus, hipDeviceAttributeMultiprocessorCount, dev) != hipSuccess) { fprintf(stderr, "kernel_launch: device query failed\n"); grid = -1; return; }
        if (hipFuncSetAttribute((const void*)enc_fwd, hipFuncAttributeMaxDynamicSharedMemorySize, LDS_BYTES) != hipSuccess) { fprintf(stderr, "kernel_launch: hipFuncSetAttribute failed\n"); grid = -1; return; }
        if (hipOccupancyMaxActiveBlocksPerMultiprocessor(&per_cu, (const void*)enc_fwd, NWAVES * 64, LDS_BYTES) != hipSuccess || per_cu < 1)
            fprintf(stderr, "kernel_launch: note: occupancy query reports %d workgroups per CU\n", per_cu);
        (void)hipGetLastError();
        grid = cus;
    }
    if (grid < 0) return;
    if (hipMemsetAsync((char*)d_ws + WS_CTL, 0, CTL_ZERO_BYTES, stream) != hipSuccess) { fprintf(stderr, "kernel_launch: memset failed\n"); return; }
    Ptrs a{};
    for (int i = 0; i < 26; ++i) a.in[i] = (const float*)d_in[i];
    a.out = (float*)d_out; a.ws = (unsigned char*)d_ws;
#if MK_PER_PHASE
    for (int ph = 0; ph < N_PHASES; ++ph) { a.ph_lo = ph; a.ph_hi = ph + 1; hipLaunchKernelGGL(enc_fwd, dim3(grid), dim3(NWAVES * 64), LDS_BYTES, stream, a); }
#else
    a.ph_lo = 0; a.ph_hi = N_PHASES;
    hipLaunchKernelGGL(enc_fwd, dim3(grid), dim3(NWAVES * 64), LDS_BYTES, stream, a);
#endif
    const hipError_t le = hipPeekAtLastError();
    if (le != hipSuccess) fprintf(stderr, "kernel_launch: launch failed: %s\n", hipGetErrorName(le));
}
```

```cpp
#include <hip/hip_runtime.h>
#include <cstdio>
#include <cstdint>
#ifndef PG8_WGM
#define PG8_WGM 6
#endif
namespace pg8 {
#define PG8_LAS __attribute__((address_space(3)))
typedef unsigned short bf16_t;
typedef short bf16x8 __attribute__((ext_vector_type(8)));
typedef float f32x4 __attribute__((ext_vector_type(4)));
typedef unsigned u32x4 __attribute__((ext_vector_type(4)));
constexpr int BM = 256, BK = 64, HALF = 128, HTB = HALF * BK * 2  , STAGE_BYTES = 8 * HTB, NXCD = 8, WGM = PG8_WGM;

__host__ __device__ __forceinline__ int lds_byte(int r, int c) { const int st = (r >> 4) * 2 + (c >> 5), rr = r & 15, cc = c & 31, ob = rr * 64 + cc * 2; return st * 1024 + (ob ^ (((ob >> 9) & 1) << 5)); }
__host__ __device__ __forceinline__ void stage_rc(int b, int& R, int& C) { const int st = b / 1024, sb = b % 1024, swz = sb ^ (((sb >> 9) & 1) << 5); R = (st >> 1) * 16 + swz / 64; C = (st & 1) * 32 + (swz % 64) / 2; }
__host__ __device__ __forceinline__ int perm32(int rho) { const int n = rho >> 4, i = rho & 15; return 8 * (i >> 2) + 4 * n + (i & 3); }

struct Unit { int pm, pn; };
struct Gemm { const bf16_t* A; const bf16_t* Bt; int M, N, K; };

struct StaticOrder {
    int nM, nN, nwg, G, c, pm0;
    __host__ __device__ void init(int M, int N, int G_, int c_) { nM = M / BM; nN = N / BM; nwg = nM * nN; G = G_; c = c_; pm0 = 0; }
    __host__ __device__ void init_part(int nMp, int pm0_, int N, int G_, int c_) { nM = nMp; nN = N / BM; nwg = nM * nN; G = G_; c = c_; pm0 = pm0_; }
    __host__ __device__ bool next(int i, Unit& u) const {
        const long L = (long)i * G + c; if (L >= nwg) return false;
        int wgid = (int)L; { const int q = nwg / NXCD, r = nwg % NXCD, xcd = wgid % NXCD, off = wgid / NXCD; wgid = (xcd < r ? xcd * (q + 1) : r * (q + 1) + (xcd - r) * q) + off; }
        const int nig = WGM * nN, gid = wgid / nig, fm = gid * WGM, gsz = (nM - fm) < WGM ? (nM - fm) : WGM;
        u.pm = pm0 + fm + ((wgid % nig) % gsz); u.pn = (wgid % nig) / gsz; return true;
    }
    __device__ __forceinline__ void a_ready(const Unit&) const {}
    __device__ __forceinline__ void done(const Unit&) const {}
};

__device__ __forceinline__ unsigned cvt_pk_bf16(float lo, float hi) { unsigned r; asm volatile("v_cvt_pk_bf16_f32 %0, %1, %2" : "=v"(r) : "v"(lo), "v"(hi)); return r; }
typedef float f32x2 __attribute__((ext_vector_type(2)));
__device__ __forceinline__ f32x2 gelu_pk(f32x2 v) {
    const f32x2 av = __builtin_elementwise_abs(v), d = av * 0.2316418882f + 1.0f;
    f32x2 t; t.x = __builtin_amdgcn_rcpf(d.x); t.y = __builtin_amdgcn_rcpf(d.y);
    f32x2 q = t * 0.5307027145f + (-0.7265760135f); q = q * t + 0.7107068705f; q = q * t + (-0.142248368f); q = q * t + 0.127414796f; q = q * t;
    const f32x2 s = (v * v) * (-0.72134752044f);
    f32x2 e; e.x = __builtin_amdgcn_exp2f(s.x); e.y = __builtin_amdgcn_exp2f(s.y);
    const f32x2 m = v * (q * e), r = v - m;
    f32x2 o; o.x = v.x < 0.f ? m.x : r.x; o.y = v.y < 0.f ? m.y : r.y; return o;
}

template <int ACT  > struct EpiBf16 {
    static constexpr bool PERM = true, AFTER_DRAIN = false; static_assert(ACT == 0 || ACT == 1, "EpiBf16: ACT is 0 (none) or 1 (gelu_pk)");
    bf16_t* O; int ldc; const float* bias; int split_cols; size_t split_stride; float scale0;
    __device__ __forceinline__ void operator()(const f32x4 (&acc)[2][2][4][2], const Unit& u, int wr, int wc, int fr, int fq) const {
        const int row0 = u.pm * BM + wr * 64 + fr; int colt = u.pn * BM; bf16_t* base = O;
        float sc = 1.f; if (split_cols) { const int t = colt / split_cols; base += (size_t)t * split_stride; colt -= t * split_cols; if (t == 0) sc = scale0; }
        const int col0 = colt + wc * 32 + 8 * fq, bcol0 = u.pn * BM + wc * 32 + 8 * fq;
        f32x4 bv[2][2];
#pragma unroll
        for (int bj = 0; bj < 2; ++bj)
#pragma unroll
            for (int n = 0; n < 2; ++n) bv[bj][n] = bias ? *(const f32x4*)(bias + bcol0 + bj * HALF + 4 * n) : (f32x4){0.f, 0.f, 0.f, 0.f};
#pragma unroll
        for (int ai = 0; ai < 2; ++ai)
#pragma unroll
            for (int m = 0; m < 4; ++m) { bf16_t* rowp = base + (size_t)(row0 + ai * HALF + m * 16) * ldc + col0;
#pragma unroll
                for (int bj = 0; bj < 2; ++bj) { f32x4 v0 = acc[ai][bj][m][0] + bv[bj][0], v1 = acc[ai][bj][m][1] + bv[bj][1];
                    if (ACT == 1) { f32x2 a = gelu_pk((f32x2){v0[0], v0[1]}), b = gelu_pk((f32x2){v0[2], v0[3]}), c = gelu_pk((f32x2){v1[0], v1[1]}), d = gelu_pk((f32x2){v1[2], v1[3]});
                        v0 = (f32x4){a.x, a.y, b.x, b.y}; v1 = (f32x4){c.x, c.y, d.x, d.y}; }
                    v0 = v0 * sc; v1 = v1 * sc; u32x4 w; w.x = cvt_pk_bf16(v0[0], v0[1]); w.y = cvt_pk_bf16(v0[2], v0[3]); w.z = cvt_pk_bf16(v1[0], v1[1]); w.w = cvt_pk_bf16(v1[2], v1[3]);
                    *(u32x4*)(rowp + bj * HALF) = w; } }
    }
};

template <class Epi, class Sched, bool ALIGN_EPI = false, bool SP2 = false>
__device__ __forceinline__ void gemm_phase(PG8_LAS unsigned char* lds, const Gemm g, const Sched& S, const Epi& E) {
    const int tid = threadIdx.x, wid = __builtin_amdgcn_readfirstlane(tid >> 6), lane = tid & 63, wr = wid >> 2, wc = wid & 3, fr = lane & 15, fq = lane >> 4;
    const int K = g.K, nt = K / BK;
    unsigned voffA[2], voffB[2];
#pragma unroll
    for (int i = 0; i < 2; ++i) { int R, C; stage_rc(tid * 16 + i * 8192, R, C); const int Rb = Epi::PERM ? ((R & ~31) + perm32(R & 31)) : R;
        voffA[i] = (unsigned)(R * K + C) * 2u; voffB[i] = (unsigned)(Rb * K + C) * 2u; }
    const size_t kstep = (size_t)(BK * 2);
    const size_t hstep = (size_t)HALF * K * 2;
    const size_t tstep = 2 * hstep;
    const unsigned ldsw = (unsigned)wid * 1024u;
    const int aoff = lds_byte(wr * 64 + fr, fq * 8), boff = lds_byte(wc * 32 + fr, fq * 8);
#define PG8_SA(b, h) (((b) * 2 + (h)) * HTB)
#define PG8_SB(b, h) ((4 + (b) * 2 + (h)) * HTB)
#define PG8_STAGE(bufoff, gbase, voff) do { _Pragma("unroll") for (int _i = 0; _i < 2; ++_i) \
        __builtin_amdgcn_global_load_lds((const unsigned*)((const char*)(gbase) + (voff)[_i]), (PG8_LAS unsigned*)(lds + (bufoff) + ldsw + _i * 8192), 16, 0, 0); } while (0)
#define PG8_LDA(dst, b, h) do { _Pragma("unroll") for (int m = 0; m < 4; ++m) _Pragma("unroll") for (int k = 0; k < 2; ++k) dst[m][k] = *(const PG8_LAS bf16x8*)(lds + PG8_SA(b, h) + aoff + m * 2048 + k * 1024); } while (0)
#define PG8_LDB(dst, b, h) do { _Pragma("unroll") for (int n = 0; n < 2; ++n) _Pragma("unroll") for (int k = 0; k < 2; ++k) dst[n][k] = *(const PG8_LAS bf16x8*)(lds + PG8_SB(b, h) + boff + n * 2048 + k * 1024); } while (0)
#define PG8_MMA(ai, bj, At, Bt) do { __builtin_amdgcn_s_setprio(1); _Pragma("unroll") for (int m = 0; m < 4; ++m) _Pragma("unroll") for (int n = 0; n < 2; ++n) _Pragma("unroll") for (int k = 0; k < 2; ++k) \
        acc[ai][bj][m][n] = __builtin_amdgcn_mfma_f32_16x16x32_bf16(Bt[n][k], At[m][k], acc[ai][bj][m][n], 0, 0, 0); __builtin_amdgcn_s_setprio(0); } while (0)
#define PG8_WAIT_V(n) asm volatile("s_waitcnt vmcnt(" #n ")" ::: "memory")
#define PG8_WAIT_L(n) asm volatile("s_waitcnt lgkmcnt(" #n ")" ::: "memory")
#define PG8_BAR __builtin_amdgcn_s_barrier()
#define PG8_SCHED __builtin_amdgcn_sched_barrier(0)
    Unit cur, nxt; int ui = 0;
    if (!S.next(0, cur)) return;
    f32x4 acc[2][2][4][2];
#pragma unroll
    for (int a = 0; a < 2; ++a)
#pragma unroll
        for (int b = 0; b < 2; ++b)
#pragma unroll
            for (int m = 0; m < 4; ++m)
#pragma unroll
                for (int n = 0; n < 2; ++n) acc[a][b][m][n] = (f32x4){0.f, 0.f, 0.f, 0.f};
    bf16x8 At[4][2], B0[2][2], B1[2][2];
    const char* cA = (const char*)g.A + (size_t)cur.pm * tstep; const char* cB = (const char*)g.Bt + (size_t)cur.pn * tstep;
    S.a_ready(cur);
    if constexpr (SP2) {
        PG8_STAGE(PG8_SB(0, 0), cB, voffB); PG8_STAGE(PG8_SB(0, 1), cB + hstep, voffB); PG8_STAGE(PG8_SA(0, 0), cA, voffA); PG8_STAGE(PG8_SA(0, 1), cA + hstep, voffA);
        if (wr == 1) PG8_BAR;
        PG8_WAIT_V(2); PG8_BAR;
        PG8_STAGE(PG8_SB(1, 0), cB + kstep, voffB); PG8_STAGE(PG8_SA(1, 0), cA + kstep, voffA); PG8_STAGE(PG8_SB(1, 1), cB + hstep + kstep, voffB);
        PG8_WAIT_V(6); PG8_BAR;
    } else {
        PG8_STAGE(PG8_SB(0, 0), cB, voffB); PG8_STAGE(PG8_SA(0, 0), cA, voffA); PG8_STAGE(PG8_SB(0, 1), cB + hstep, voffB); PG8_STAGE(PG8_SA(0, 1), cA + hstep, voffA);
        if (wr == 1) PG8_BAR;
        PG8_WAIT_V(4); PG8_BAR;
        PG8_STAGE(PG8_SB(1, 0), cB + kstep, voffB); PG8_STAGE(PG8_SA(1, 0), cA + kstep, voffA); PG8_STAGE(PG8_SB(1, 1), cB + hstep + kstep, voffB);
        PG8_WAIT_V(6); PG8_BAR;
    }
    for (;;) {
        const bool has_next = S.next(ui + 1, nxt);
        const char* nA = has_next ? (const char*)g.A + (size_t)nxt.pm * tstep : cA; const char* nB = has_next ? (const char*)g.Bt + (size_t)nxt.pn * tstep : cB;
        for (int t = 0; t < nt; t += 2) {
            const bool last = (t == nt - 2);
            const char* a1 = cA + (size_t)(t + 1) * kstep;
            const char* a2 = last ? nA : cA + (size_t)(t + 2) * kstep; const char* b2 = last ? nB : cB + (size_t)(t + 2) * kstep;
            const char* a3 = a2 + kstep; const char* b3 = b2 + kstep;
            if (last && has_next) S.a_ready(nxt);
            if constexpr (SP2) {
            PG8_LDB(B0, 0, 0); PG8_LDB(B1, 0, 1); PG8_SCHED; PG8_LDA(At, 0, 0); PG8_STAGE(PG8_SA(1, 1), a1 + hstep, voffA);
            PG8_WAIT_V(8); PG8_WAIT_L(0); PG8_BAR; PG8_MMA(0, 0, At, B0); PG8_MMA(0, 1, At, B1); PG8_BAR; PG8_SCHED;
            PG8_LDA(At, 0, 1); PG8_STAGE(PG8_SB(0, 0), b2, voffB); PG8_STAGE(PG8_SB(0, 1), b2 + hstep, voffB); PG8_STAGE(PG8_SA(0, 0), a2, voffA);
            PG8_WAIT_V(8); PG8_WAIT_L(0); PG8_BAR; PG8_MMA(1, 0, At, B0); PG8_MMA(1, 1, At, B1); PG8_BAR; PG8_SCHED;
            PG8_LDB(B0, 1, 0); PG8_LDB(B1, 1, 1); PG8_SCHED; PG8_LDA(At, 1, 0); PG8_STAGE(PG8_SA(0, 1), a2 + hstep, voffA);
            PG8_WAIT_V(8); PG8_WAIT_L(0); PG8_BAR; PG8_MMA(0, 0, At, B0); PG8_MMA(0, 1, At, B1); PG8_BAR; PG8_SCHED;
            PG8_LDA(At, 1, 1); PG8_STAGE(PG8_SB(1, 0), b3, voffB); PG8_STAGE(PG8_SB(1, 1), b3 + hstep, voffB); PG8_STAGE(PG8_SA(1, 0), a3, voffA);
            PG8_WAIT_V(8); PG8_WAIT_L(0); PG8_BAR; PG8_MMA(1, 0, At, B0); PG8_MMA(1, 1, At, B1); PG8_BAR; PG8_SCHED;
            } else {
            PG8_LDB(B0, 0, 0); PG8_SCHED; PG8_LDA(At, 0, 0); PG8_STAGE(PG8_SA(1, 1), a1 + hstep, voffA);
            PG8_WAIT_L(8); PG8_BAR; PG8_WAIT_L(0); PG8_MMA(0, 0, At, B0); PG8_BAR; PG8_SCHED;
            PG8_LDB(B1, 0, 1); PG8_STAGE(PG8_SB(0, 0), b2, voffB);
            PG8_BAR; PG8_WAIT_L(0); PG8_MMA(0, 1, At, B1); PG8_BAR;
            PG8_LDA(At, 0, 1); PG8_STAGE(PG8_SA(0, 0), a2, voffA);
            PG8_BAR; PG8_WAIT_L(0); PG8_MMA(1, 0, At, B0); PG8_BAR; PG8_SCHED;
            PG8_STAGE(PG8_SB(0, 1), b2 + hstep, voffB);
            PG8_WAIT_V(6); PG8_BAR; PG8_MMA(1, 1, At, B1); PG8_BAR;
            PG8_LDB(B0, 1, 0); PG8_SCHED; PG8_LDA(At, 1, 0); PG8_STAGE(PG8_SA(0, 1), a2 + hstep, voffA);
            PG8_WAIT_L(8); PG8_BAR; PG8_WAIT_L(0); PG8_MMA(0, 0, At, B0); PG8_BAR; PG8_SCHED;
            PG8_LDB(B1, 1, 1); PG8_STAGE(PG8_SB(1, 0), b3, voffB);
            PG8_BAR; PG8_WAIT_L(0); PG8_MMA(0, 1, At, B1); PG8_BAR;
            PG8_LDA(At, 1, 1); PG8_STAGE(PG8_SA(1, 0), a3, voffA);
            PG8_BAR; PG8_WAIT_L(0); PG8_MMA(1, 0, At, B0); PG8_BAR; PG8_SCHED;
            PG8_STAGE(PG8_SB(1, 1), b3 + hstep, voffB);
            PG8_WAIT_V(6); PG8_BAR; PG8_MMA(1, 1, At, B1); PG8_BAR;
            }
        }
        if constexpr (ALIGN_EPI) { if (wr == 0) PG8_BAR; }
        if constexpr (!Epi::AFTER_DRAIN) { E(acc, cur, wr, wc, fr, fq); S.done(cur); }
        if (!has_next) break;
#pragma unroll
        for (int a = 0; a < 2; ++a)
#pragma unroll
            for (int b = 0; b < 2; ++b)
#pragma unroll
                for (int m = 0; m < 4; ++m)
#pragma unroll
                    for (int n = 0; n < 2; ++n) acc[a][b][m][n] = (f32x4){0.f, 0.f, 0.f, 0.f};
        cur = nxt; cA = nA; cB = nB; ++ui;
        if constexpr (ALIGN_EPI) { if (wr == 1) PG8_BAR; }
    }
    PG8_WAIT_V(0);
    if constexpr (!ALIGN_EPI) { if (wr == 0) PG8_BAR; }
    PG8_BAR;
    if constexpr (Epi::AFTER_DRAIN) { E.fused(acc, cur, wr, wc, fr, fq, lds, wid, lane); S.done(cur); }
#undef PG8_SA
#undef PG8_SB
#undef PG8_STAGE
#undef PG8_LDA
#undef PG8_LDB
#undef PG8_MMA
#undef PG8_WAIT_V
#undef PG8_WAIT_L
#undef PG8_BAR
#undef PG8_SCHED
}
}
#define GAS __attribute__((address_space(1)))
#define LAS __attribute__((address_space(3)))
typedef unsigned short bf16;
typedef unsigned v4u __attribute__((ext_vector_type(4)));
typedef float f32x4 __attribute__((ext_vector_type(4)));
typedef short bf16x8 __attribute__((ext_vector_type(8)));
typedef GAS unsigned gu32;
typedef GAS unsigned long long gu64;
#define RLX_AGENT __ATOMIC_RELAXED, __HIP_MEMORY_SCOPE_AGENT
#define LDS_WAIT() asm volatile("s_waitcnt lgkmcnt(0)" ::: "memory")
#define VM_WAIT() asm volatile("s_waitcnt vmcnt(0)" ::: "memory")
__device__ __forceinline__ unsigned long long rt() { return __builtin_amdgcn_s_memrealtime(); }
__device__ __forceinline__ unsigned f2bf(float f) { unsigned u = __builtin_bit_cast(unsigned, f); return (u + 0x7fffu + ((u >> 16) & 1u)) >> 16; }
__device__ __forceinline__ unsigned pk2(float lo, float hi) { return f2bf(lo) | (f2bf(hi) << 16); }

#define XB_TMO      128
#define XB_XCNT(j)  (256  + 64 * (j))
#define XB_XSUB(j)  (1280 + 64 * (j))
#define XB_XGEN(j)  (2304 + 64 * (j))
#define XB_TOP      3328
#define XB_TOPGEN   3392
#define XCD_BAR_WORDS 3456
#define XB_SPIN_CAP (1u << 18)

__device__ __forceinline__ unsigned xb_ld(unsigned* p)              { return __hip_atomic_load(p, __ATOMIC_RELAXED, __HIP_MEMORY_SCOPE_AGENT); }
__device__ __forceinline__ unsigned xb_add(unsigned* p, unsigned v) { return __hip_atomic_fetch_add(p, v, __ATOMIC_RELAXED, __HIP_MEMORY_SCOPE_AGENT); }
__device__ __forceinline__ unsigned xb_xcc_id() { return (unsigned)__builtin_amdgcn_s_getreg((3 << 11) | 20) & 0xFu; }
#define XB_SPIN(cond, bar) do { unsigned _sp = 0; while (cond) { __builtin_amdgcn_s_sleep(1); \
    if ((++_sp & 255u) == 0u) { if (xb_ld(&(bar)[XB_TMO])) break; if (_sp > XB_SPIN_CAP) { atomicAdd(&(bar)[XB_TMO], 1u); break; } } } } while (0)

struct XcdBarrier {
    unsigned* bar; unsigned x;
    volatile LAS unsigned* st;
};

__device__ __forceinline__ XcdBarrier xcd_barrier_post(unsigned* bar, volatile LAS unsigned* st) {
    XcdBarrier b; b.bar = bar; b.x = xb_xcc_id(); b.st = st;
    if (threadIdx.x == 0) (void)xb_add(&bar[XB_XCNT(b.x)], 1u);
    return b;
}
__device__ __forceinline__ void xcd_barrier_complete(unsigned* bar, unsigned x, unsigned& nloc, unsigned& nx) {
    const unsigned G = gridDim.x * gridDim.y * gridDim.z;
    unsigned sum, cnt, mine, sp = 0u;
    for (;;) {
        sum = 0u; cnt = 0u; mine = 0u;
#pragma unroll
        for (unsigned j = 0; j < 16; ++j) { const unsigned c = xb_ld(&bar[XB_XCNT(j)]); sum += c; cnt += (c > 0u) ? 1u : 0u; mine = (j == x) ? c : mine; }
        if (sum == G) break;
        __builtin_amdgcn_s_sleep(1);
        if ((++sp & 255u) == 0u) { if (xb_ld(&bar[XB_TMO])) break; if (sp > XB_SPIN_CAP) { atomicAdd(&bar[XB_TMO], 1u); break; } }
    }
    nloc = mine > 0u ? mine : 1u; nx = cnt > 0u ? cnt : 1u;
}

__device__ __forceinline__ void xcd_barrier(const XcdBarrier& b) {
    asm volatile("s_waitcnt vmcnt(0)" ::: "memory");
    __syncthreads();
    if (threadIdx.x == 0) {
        unsigned* bar = b.bar;
        __builtin_amdgcn_s_waitcnt(0);
        unsigned nloc = b.st[0], nx = b.st[1];
        if (nloc == 0u) { xcd_barrier_complete(bar, b.x, nloc, nx); b.st[0] = nloc; b.st[1] = nx; }
        const unsigned old = xb_add(&bar[XB_XSUB(b.x)], 1u);
        const unsigned gen = old / nloc;
        if (old + 1u == (gen + 1u) * nloc) {
            __builtin_amdgcn_fence(__ATOMIC_RELEASE, "agent");
            asm volatile("s_waitcnt vmcnt(0)" ::: "memory");
            const unsigned og = xb_add(&bar[XB_TOP], 1u);
            const unsigned tg = og / nx;
            if (og + 1u == (tg + 1u) * nx) xb_add(&bar[XB_TOPGEN], 1u);
            else XB_SPIN(xb_ld(&bar[XB_TOPGEN]) == tg, bar);
            __builtin_amdgcn_fence(__ATOMIC_ACQUIRE, "agent");
            xb_add(&bar[XB_XGEN(b.x)], 1u);
            asm volatile("s_waitcnt vmcnt(0)" ::: "memory");
        } else {
            XB_SPIN(xb_ld(&bar[XB_XGEN(b.x)]) == gen, bar);
            __builtin_amdgcn_fence(__ATOMIC_ACQUIRE, "agent");
            asm volatile("s_waitcnt vmcnt(0)" ::: "memory");
        }
    }
    __syncthreads();
}

constexpr int NWAVES = 8;
constexpr int DM = 2048, SEQ = 16384, NBATCH = 2, MP = NBATCH * SEQ, DECB = 32, DECS = 32, MS = DECB * DECS, M = MP + MS, PAST = 2048;
constexpr int NPM = M / 256, NPM_P = MP / 256;
constexpr float ALPHA = 1.6817928305074290f;
constexpr float LN_EPS = 1e-5f;
constexpr float SB_SCALE = 0.08838834764831845f;
#ifndef SB_CUT_VAL
#define SB_CUT_VAL -104.0f
#endif
constexpr float SB_CUT = SB_CUT_VAL;
constexpr float SB_QSCALE = SB_SCALE * 1.4426950408889634f;
constexpr float SB_CUT2 = SB_CUT * 1.4426950408889634f - 0.1f;
constexpr size_t O_YP = 0, O_YS = O_YP + (size_t)MP * DM, O_KAP = O_YS + (size_t)MS * DM, O_VAP = O_KAP + 2ull * MP * 1024, O_KAS = O_VAP + 2ull * MP * 1024,
    O_VAS = O_KAS + 2ull * MS * 1024, O_KBP = O_VAS + 2ull * MS * 1024, O_VBP = O_KBP + 2ull * 128 * 256, O_KBS = O_VBP + 2ull * 128 * 256, O_VBS = O_KBS + (size_t)MS * 256,
    O_HRP = O_VBS + (size_t)MS * 256, O_HIP = O_HRP + 2 * 64 * 64, O_HRS = O_HIP + 2 * 64 * 64, O_HIS = O_HRS + 32 * 64 * 64, O_END = O_HIS + 32 * 64 * 64;
constexpr size_t MiB = 1u << 20;
constexpr size_t WS_CTL = 0, CTL_ZERO_BYTES = 2 * MiB;
constexpr size_t WS_C1C2 = 65536, WS_STATS = 262144;
constexpr size_t WS_SSMC = 86 * MiB;
constexpr size_t WS_WINA0 = 2 * MiB, WS_WINA1 = 18 * MiB, WS_WOUTA0 = 34 * MiB, WS_WOUTA1 = 38 * MiB, WS_WINB = 42 * MiB, WS_WOUTB = 60 * MiB, WS_WINC = 68 * MiB, WS_WGLU = 76 * MiB, WS_WOUTC = 78 * MiB;
constexpr size_t WS_BBB = 84 * MiB, WS_CMB = 85 * MiB;
constexpr size_t WS_XB = 96 * MiB;
constexpr size_t WS_XF = 256 * MiB;
constexpr size_t WS_PROJ = 520 * MiB;
constexpr size_t WS_AO = 832 * MiB;
constexpr size_t WS_AOC = 900 * MiB;
constexpr size_t WS_SEND = 968 * MiB, WS_HIN = 984 * MiB, WS_END = 1000 * MiB;
constexpr int CW_TMO = 0, CW_CODE = 1, CW_BAR = 4096;
constexpr int RING_OFF = 0, RING_BYTES = 131072, LDSCTL_OFF = RING_BYTES, MISC_OFF = LDSCTL_OFF + 320, LDS_BYTES = 147456;

struct Frame {
    LAS unsigned char* lds;
    volatile LAS unsigned* MISC;
    gu32* ctl;
    int tid, lane, wave;
    int vcu, G;
};
typedef float f32x2v __attribute__((ext_vector_type(2)));
__device__ __forceinline__ float bflo(unsigned v) { return __uint_as_float(v << 16); }
__device__ __forceinline__ float bfhi(unsigned v) { return __uint_as_float(v & 0xffff0000u); }
__device__ __forceinline__ float wave_sum(float v) {
#pragma unroll
    for (int o = 1; o < 64; o <<= 1) v += __shfl_xor(v, o);
    return v;
}
__device__ __forceinline__ float wave_max(float v) {
#pragma unroll
    for (int o = 1; o < 64; o <<= 1) v = fmaxf(v, __shfl_xor(v, o));
    return v;
}
__device__ __forceinline__ float silu_f(float g) { return g / (1.0f + __expf(-g)); }
__device__ __forceinline__ float gelu_tanh_f(float x) { const float a = 0.7978845608028654f * (x + 0.044715f * x * x * x); const float e = __expf(2.0f * a); return 0.5f * x * (2.0f - 2.0f / (1.0f + e)); }

__device__ __forceinline__ void p0_transpose_item(const float* W, int K, int N, bf16* WT, LAS float* scr, int item, int lane, const float* g, const float* b, float* c1, float* c2) {
    const int nblk = N / 32, kb = item / nblk, nb = item % nblk, k0 = 64 * kb, n0 = 32 * nb;
    { float wv[32];
#pragma unroll
      for (int i = 0; i < 32; ++i) wv[i] = W[(size_t)(k0 + 2 * i + (lane >> 5)) * N + n0 + (lane & 31)];
#pragma unroll
      for (int i = 0; i < 32; ++i) scr[(2 * i + (lane >> 5)) * 33 + (lane & 31)] = wv[i]; }
    LDS_WAIT(); asm volatile("" ::: "memory");
    const int c = lane & 7;
    f32x4 g0 = {1.f, 1.f, 1.f, 1.f}, g1 = g0, b0 = {0.f, 0.f, 0.f, 0.f}, b1 = b0;
    if (g) { g0 = *(const GAS f32x4*)(g + k0 + 8 * c); g1 = *(const GAS f32x4*)(g + k0 + 8 * c + 4); b0 = *(const GAS f32x4*)(b + k0 + 8 * c); b1 = *(const GAS f32x4*)(b + k0 + 8 * c + 4); }
#pragma unroll
    for (int j = 0; j < 4; ++j) { const int n = (lane >> 3) + 8 * j; const LAS float* s = scr + (8 * c) * 33 + n;
        const float w0 = s[0 * 33], w1 = s[1 * 33], w2 = s[2 * 33], w3 = s[3 * 33], w4 = s[4 * 33], w5 = s[5 * 33], w6 = s[6 * 33], w7 = s[7 * 33];
        v4u o; o.x = pk2(w0 * g0.x, w1 * g0.y); o.y = pk2(w2 * g0.z, w3 * g0.w); o.z = pk2(w4 * g1.x, w5 * g1.y); o.w = pk2(w6 * g1.z, w7 * g1.w);
        *(GAS v4u*)(WT + (size_t)(n0 + n) * K + k0 + 8 * c) = o;
        if (g) {
            float s1 = ((bflo(o.x) + bfhi(o.x)) + (bflo(o.y) + bfhi(o.y))) + ((bflo(o.z) + bfhi(o.z)) + (bflo(o.w) + bfhi(o.w)));
            float s2 = ((w0 * b0.x + w1 * b0.y) + (w2 * b0.z + w3 * b0.w)) + ((w4 * b1.x + w5 * b1.y) + (w6 * b1.z + w7 * b1.w));
            s1 += __shfl_xor(s1, 1); s2 += __shfl_xor(s2, 1); s1 += __shfl_xor(s1, 2); s2 += __shfl_xor(s2, 2); s1 += __shfl_xor(s1, 4); s2 += __shfl_xor(s2, 4);
            if (c == 0) { const float o1 = unsafeAtomicAdd(c1 + n0 + n, s1), o2 = unsafeAtomicAdd(c2 + n0 + n, s2); asm volatile("" :: "v"(o1), "v"(o2)); }
        } }
    LDS_WAIT(); asm volatile("" ::: "memory");
}

struct Ptrs {
    const float* in[26]; float* out; unsigned char* ws; int ph_lo, ph_hi;
};

__device__ __forceinline__ void sincos_d(double x, double& s, double& c) {
    const double TWO_PI = 6.283185307179586476925286766559;
    x -= TWO_PI * rint(x / TWO_PI);
    const double q = x * 0.25, q2 = q * q;
    double sp = 1.0 / 6227020800.0; sp = sp * q2 - 1.0 / 39916800.0; sp = sp * q2 + 1.0 / 362880.0; sp = sp * q2 - 1.0 / 5040.0; sp = sp * q2 + 1.0 / 120.0; sp = sp * q2 - 1.0 / 6.0; sp = sp * q2 + 1.0; sp *= q;
    double cp = 1.0 / 87178291200.0; cp = cp * q2 - 1.0 / 479001600.0; cp = cp * q2 + 1.0 / 3628800.0; cp = cp * q2 - 1.0 / 40320.0; cp = cp * q2 + 1.0 / 720.0; cp = cp * q2 - 1.0 / 24.0; cp = cp * q2 + 0.5; cp = 1.0 - cp * q2;
    double s2 = 2.0 * sp * cp, c2 = 1.0 - 2.0 * sp * sp;
    s = 2.0 * s2 * c2; c = 1.0 - 2.0 * s2 * s2;
}

constexpr int PW_R0 = 32 * 128, PW_R1 = PW_R0 + 16 * 64 + 32 * 144 + 32 * 64, PW_R2 = PW_R1 + 32 * 64 + 16 * 32 + 16 * 64 + 32 * 128 + 16 * 64;
__device__ __forceinline__ void p0_weights(Frame& F, const Ptrs& P, int lo, int hi, int vw, int nvw) {
    unsigned char* ws = P.ws;
    LAS float* scr = (LAS float*)(F.lds + RING_OFF + F.wave * 16384);
    float* const C1C2 = (float*)(ws + WS_C1C2);
    constexpr int I_INA = 32 * 128, I_OUTA = 16 * 64, I_INB = 32 * 144, I_OUTB = 32 * 64, I_INC = 32 * 64, I_GLU = 16 * 32, I_OUTC = 16 * 64;
    for (int it = lo + vw; it < hi; it += nvw) {
        int r = it;
        if (r < I_INA) { p0_transpose_item(P.in[10], 2048, 4096, (bf16*)(ws + WS_WINA0), scr, r, F.lane, nullptr, nullptr, nullptr, nullptr); continue; } r -= I_INA;
        if (r < I_OUTA) { p0_transpose_item(P.in[11], 1024, 2048, (bf16*)(ws + WS_WOUTA0), scr, r, F.lane, nullptr, nullptr, nullptr, nullptr); continue; } r -= I_OUTA;
        if (r < I_INB) { p0_transpose_item(P.in[12], 2048, 4608, (bf16*)(ws + WS_WINB), scr, r, F.lane, P.in[8], P.in[9], C1C2, C1C2 + 4608); continue; } r -= I_INB;
        if (r < I_OUTB) { p0_transpose_item(P.in[14], 2048, 2048, (bf16*)(ws + WS_WOUTB), scr, r, F.lane, nullptr, nullptr, nullptr, nullptr); continue; } r -= I_OUTB;
        if (r < I_INC) { p0_transpose_item(P.in[15], 2048, 2048, (bf16*)(ws + WS_WINC), scr, r, F.lane, P.in[8] + DM, P.in[9] + DM, C1C2 + 2 * 4608, C1C2 + 3 * 4608); continue; } r -= I_INC;
        if (r < I_GLU) { p0_transpose_item(P.in[24], 1024, 1024, (bf16*)(ws + WS_WGLU), scr, r, F.lane, nullptr, nullptr, nullptr, nullptr); continue; } r -= I_GLU;
        if (r < I_OUTC) { p0_transpose_item(P.in[25], 1024, 2048, (bf16*)(ws + WS_WOUTC), scr, r, F.lane, nullptr, nullptr, nullptr, nullptr); continue; } r -= I_OUTC;
        if (r < I_INA) { p0_transpose_item(P.in[10] + (size_t)2048 * 4096, 2048, 4096, (bf16*)(ws + WS_WINA1), scr, r, F.lane, P.in[8] + 2 * DM, P.in[9] + 2 * DM, C1C2 + 4 * 4608, C1C2 + 5 * 4608); continue; } r -= I_INA;
        p0_transpose_item(P.in[11] + (size_t)1024 * 2048, 1024, 2048, (bf16*)(ws + WS_WOUTA1), scr, r, F.lane, nullptr, nullptr, nullptr, nullptr);
    }
}
__device__ __forceinline__ void p0_prologue(Frame& F, const Ptrs& P) {
    unsigned char* ws = P.ws;
    const int gw = F.vcu * NWAVES + F.wave, NGW = F.G * NWAVES;
    p0_weights(F, P, 0, PW_R0, gw, NGW);
    bf16* XB = (bf16*)(ws + WS_XB);
    for (int m0 = 2 * gw; m0 < M; m0 += 2 * NGW) {
        f32x4 xa[2][4], xb[2][4];
#pragma unroll
        for (int r = 0; r < 2; ++r) { const int m = m0 + r; const float* xr = (m < MP) ? P.in[0] + (size_t)m * DM : P.in[1] + (size_t)(m - MP) * DM;
#pragma unroll
            for (int j = 0; j < 4; ++j) { const int c = (j * 64 + F.lane) * 8; xa[r][j] = *(const GAS f32x4*)(xr + c); xb[r][j] = *(const GAS f32x4*)(xr + c + 4); } }
        asm volatile("" ::: "memory");
#pragma unroll
        for (int r = 0; r < 2; ++r)
#pragma unroll
            for (int j = 0; j < 4; ++j) { const int c = (j * 64 + F.lane) * 8; const f32x4 a = xa[r][j], b = xb[r][j];
                v4u o; o.x = pk2(a.x, a.y); o.y = pk2(a.z, a.w); o.z = pk2(b.x, b.y); o.w = pk2(b.z, b.w); *(GAS v4u*)(XB + (size_t)(m0 + r) * DM + c) = o; }
    }
}
__device__ __forceinline__ void p0_s5tables(const Ptrs& P, int gt0, int gstride) {
    unsigned char* ws = P.ws;
    for (int gt = gt0; gt < 64 * 64; gt += gstride) {
        const int g = gt >> 6, p = gt & 63;
        float* lam = (float*)(ws + WS_SSMC); float* lam64 = lam + 64 * 64 * 2; float* BB = lam64 + 64 * 64 * 2;
        const double are = fmin((double)P.in[16][gt], -1e-4), aim = (double)P.in[17][gt];
        const double dt = exp((double)P.in[18][g]);
        const double mag = exp(dt * are); double sn, cs; sincos_d(dt * aim, sn, cs);
        const double lr = mag * cs, li = mag * sn, nre = lr - 1.0, den = are * are + aim * aim;
        const double fre = (nre * are + li * aim) / den, fim = (li * are - nre * aim) / den;
        double pr = lr, pi = li;
#pragma unroll
        for (int i = 0; i < 6; ++i) { const double nr = pr * pr - pi * pi, ni = 2.0 * pr * pi; pr = nr; pi = ni; }
        f32x4 brv[4], biv[4]; float cre[16], cim[16];
#pragma unroll
        for (int c = 0; c < 4; ++c) { brv[c] = *(const GAS f32x4*)(P.in[19] + (size_t)gt * 16 + 4 * c); biv[c] = *(const GAS f32x4*)(P.in[20] + (size_t)gt * 16 + 4 * c); }
#pragma unroll
        for (int c = 0; c < 16; ++c) { cre[c] = P.in[21][((size_t)g * 16 + c) * 64 + p]; cim[c] = P.in[22][((size_t)g * 16 + c) * 64 + p]; }
        asm volatile("" ::: "memory");
        lam[2 * gt] = (float)lr; lam[2 * gt + 1] = (float)li; lam64[2 * gt] = (float)pr; lam64[2 * gt + 1] = (float)pi;
        bf16* BBb = (bf16*)(ws + WS_BBB); bf16* Cmb = (bf16*)(ws + WS_CMB);
#pragma unroll
        for (int c = 0; c < 16; ++c) { const double br = brv[c >> 2][c & 3], bi = biv[c >> 2][c & 3]; const float xr = (float)(fre * br - fim * bi), xi = (float)(fre * bi + fim * br);
            BB[(size_t)gt * 32 + c] = xr; BB[(size_t)gt * 32 + 16 + c] = xi;
            BBb[((size_t)g * 128 + p) * 16 + c] = (bf16)f2bf(xr); BBb[((size_t)g * 128 + 64 + p) * 16 + c] = (bf16)f2bf(xi);
            Cmb[((size_t)g * 16 + c) * 128 + p] = (bf16)f2bf(cre[c]); Cmb[((size_t)g * 16 + c) * 128 + 64 + p] = (bf16)f2bf(-cim[c]); }
        (void)g; (void)p;
    }
}


namespace pg8 {
struct RowAff {
    const float* S1; const float* S2; const float* c1; const float* c2;
    __device__ __forceinline__ void cols(int col0, f32x4 (&c1v)[2][2], f32x4 (&c2v)[2][2]) const {
#pragma unroll
        for (int bj = 0; bj < 2; ++bj)
#pragma unroll
            for (int n = 0; n < 2; ++n) { c1v[bj][n] = *(const f32x4*)(c1 + col0 + bj * HALF + 4 * n); c2v[bj][n] = *(const f32x4*)(c2 + col0 + bj * HALF + 4 * n); }
    }
    __device__ __forceinline__ void row(int r, float& mu, float& rs) const { const float s1 = S1[r], s2 = S2[r]; mu = s1 * (1.0f / DM); rs = 1.0f / sqrtf(fmaxf(s2 * (1.0f / DM) - mu * mu, 0.f) + LN_EPS); }
    __device__ __forceinline__ void rows8(int row0, float (&mu)[2][4], float (&rs)[2][4]) const {
        float s1[2][4], s2[2][4];
#pragma unroll
        for (int ai = 0; ai < 2; ++ai)
#pragma unroll
            for (int m = 0; m < 4; ++m) { const int r = row0 + ai * HALF + m * 16; s1[ai][m] = S1[r]; s2[ai][m] = S2[r]; }
#pragma unroll
        for (int ai = 0; ai < 2; ++ai)
#pragma unroll
            for (int m = 0; m < 4; ++m) { mu[ai][m] = s1[ai][m] * (1.0f / DM); rs[ai][m] = 1.0f / sqrtf(fmaxf(s2[ai][m] * (1.0f / DM) - mu[ai][m] * mu[ai][m], 0.f) + LN_EPS); }
    }
};
template <bool AFF> struct EpiProjA {
    static constexpr bool PERM = true, AFTER_DRAIN = false;
    bf16_t* O; float* kp; float* vp; float* ks; float* vs; RowAff af;
    __device__ __forceinline__ void operator()(const f32x4 (&acc)[2][2][4][2], const Unit& u, int wr, int wc, int fr, int fq) const {
        const int row0 = u.pm * BM + wr * 64 + fr, colt = u.pn * BM, col0 = colt + wc * 32 + 8 * fq;
        const int sect = u.pn >> 2;
        const float sc = (sect == 0) ? SB_QSCALE : 1.0f;
        float* fbase = nullptr;
        if (sect == 1) fbase = (u.pm < NPM_P) ? kp + (size_t)row0 * 1024 : ks + (size_t)(row0 - MP) * 1024;
        if (sect == 2) fbase = (u.pm < NPM_P) ? vp + (size_t)row0 * 1024 : vs + (size_t)(row0 - MP) * 1024;
        const int fcol = col0 - sect * 1024;
        f32x4 c1v[2][2], c2v[2][2]; float mu8[2][4], rs8[2][4];
        if (AFF) { af.cols(col0, c1v, c2v); af.rows8(row0, mu8, rs8); }
#pragma unroll
        for (int ai = 0; ai < 2; ++ai)
#pragma unroll
            for (int m = 0; m < 4; ++m) { const int dr = ai * HALF + m * 16; bf16_t* rowp = O + (size_t)(row0 + dr) * 4096 + col0;
                float mu = 0.f, rs = 1.f; if (AFF) { mu = mu8[ai][m]; rs = rs8[ai][m]; }
#pragma unroll
                for (int bj = 0; bj < 2; ++bj) { f32x4 v0 = acc[ai][bj][m][0], v1 = acc[ai][bj][m][1];
                    if (AFF) { v0 = (v0 - c1v[bj][0] * mu) * rs + c2v[bj][0]; v1 = (v1 - c1v[bj][1] * mu) * rs + c2v[bj][1]; }
                    v0 = v0 * sc; v1 = v1 * sc;
                    u32x4 w; w.x = cvt_pk_bf16(v0[0], v0[1]); w.y = cvt_pk_bf16(v0[2], v0[3]); w.z = cvt_pk_bf16(v1[0], v1[1]); w.w = cvt_pk_bf16(v1[2], v1[3]);
                    *(u32x4*)(rowp + bj * HALF) = w;
                    if (fbase) { float* fp = fbase + (size_t)dr * 1024 + fcol + bj * HALF; *(f32x4*)fp = v0; *(f32x4*)(fp + 4) = v1; } } }
    }
};
struct EpiProjB {
    static constexpr bool PERM = true, AFTER_DRAIN = false;
    bf16_t* O; float* out; RowAff af;
    __device__ __forceinline__ void operator()(const f32x4 (&acc)[2][2][4][2], const Unit& u, int wr, int wc, int fr, int fq) const {
        const int row0 = u.pm * BM + wr * 64 + fr, colt = u.pn * BM, col0 = colt + wc * 32 + 8 * fq;
        const float sc = (u.pn < 8) ? 0.125f * 1.4426950408889634f : 1.0f;
        const bool kv = (u.pn == 8 || u.pn == 9);
        f32x4 c1v[2][2], c2v[2][2]; float mu8[2][4], rs8[2][4];
        af.cols(col0, c1v, c2v); af.rows8(row0, mu8, rs8);
#pragma unroll
        for (int ai = 0; ai < 2; ++ai)
#pragma unroll
            for (int m = 0; m < 4; ++m) { const int row = row0 + ai * HALF + m * 16; bf16_t* rowp = O + (size_t)row * 4608 + col0;
                const float mu = mu8[ai][m], rs = rs8[ai][m];
                float* fp = nullptr;
                if (kv) {
                    if (row >= MP) fp = out + (u.pn == 8 ? O_KBS : O_VBS) + (size_t)(row - MP) * 256;
                    else { const int b = row / SEQ, t = row % SEQ; if (t >= SEQ - 128) fp = out + (u.pn == 8 ? O_KBP : O_VBP) + ((size_t)b * 128 + (t - (SEQ - 128))) * 256; }
                    if (fp) fp += (col0 - colt);
                }
#pragma unroll
                for (int bj = 0; bj < 2; ++bj) { f32x4 v0 = acc[ai][bj][m][0], v1 = acc[ai][bj][m][1];
                    v0 = ((v0 - c1v[bj][0] * mu) * rs + c2v[bj][0]) * sc; v1 = ((v1 - c1v[bj][1] * mu) * rs + c2v[bj][1]) * sc;
                    u32x4 w; w.x = cvt_pk_bf16(v0[0], v0[1]); w.y = cvt_pk_bf16(v0[2], v0[3]); w.z = cvt_pk_bf16(v1[0], v1[1]); w.w = cvt_pk_bf16(v1[2], v1[3]);
                    *(u32x4*)(rowp + bj * HALF) = w;
                    if (fp) { *(f32x4*)(fp + bj * HALF) = v0; *(f32x4*)(fp + bj * HALF + 4) = v1; } } }
    }
};
struct EpiProjC {
    static constexpr bool PERM = true, AFTER_DRAIN = false;
    bf16_t* O; RowAff af;
    __device__ __forceinline__ void operator()(const f32x4 (&acc)[2][2][4][2], const Unit& u, int wr, int wc, int fr, int fq) const {
        const int row0 = u.pm * BM + wr * 64 + fr, col0 = u.pn * BM + wc * 32 + 8 * fq;
        f32x4 c1v[2][2], c2v[2][2]; float mu8[2][4], rs8[2][4];
        af.cols(col0, c1v, c2v); af.rows8(row0, mu8, rs8);
#pragma unroll
        for (int ai = 0; ai < 2; ++ai)
#pragma unroll
            for (int m = 0; m < 4; ++m) { const int row = row0 + ai * HALF + m * 16; bf16_t* rowp = O + (size_t)row * 2048 + col0;
                const float mu = mu8[ai][m], rs = rs8[ai][m];
#pragma unroll
                for (int bj = 0; bj < 2; ++bj) { const f32x4 v0 = (acc[ai][bj][m][0] - c1v[bj][0] * mu) * rs + c2v[bj][0], v1 = (acc[ai][bj][m][1] - c1v[bj][1] * mu) * rs + c2v[bj][1];
                    u32x4 w; w.x = cvt_pk_bf16(v0[0], v0[1]); w.y = cvt_pk_bf16(v0[2], v0[3]); w.z = cvt_pk_bf16(v1[0], v1[1]); w.w = cvt_pk_bf16(v1[2], v1[3]);
                    *(u32x4*)(rowp + bj * HALF) = w; } }
    }
};
struct EpiResid {
    static constexpr bool PERM = false, AFTER_DRAIN = false;
    const float* xp; const float* xs; float* Z;
    __device__ __forceinline__ void operator()(const f32x4 (&acc)[2][2][4][2], const Unit& u, int wr, int wc, int fr, int fq) const {
        const int row0 = u.pm * BM + wr * 64 + fr, col0 = u.pn * BM + wc * 32 + 4 * fq;
        const float* xb = (u.pm < NPM_P) ? xp + (size_t)row0 * DM : xs + (size_t)(row0 - MP) * DM;
        float* zb = Z + (size_t)row0 * DM;
#pragma unroll
        for (int ai = 0; ai < 2; ++ai)
#pragma unroll
            for (int m = 0; m < 4; ++m) { const size_t off = (size_t)(ai * HALF + m * 16) * DM + col0;
#pragma unroll
                for (int bj = 0; bj < 2; ++bj)
#pragma unroll
                    for (int n = 0; n < 2; ++n) { const f32x4 xv = *(const f32x4*)(xb + off + bj * HALF + n * 16); *(f32x4*)(zb + off + bj * HALF + n * 16) = xv * ALPHA + acc[ai][bj][m][n]; } }
    }
};
struct EpiGlu {
    static constexpr bool PERM = true, AFTER_DRAIN = false;
    const bf16_t* Y1; const bf16_t* PROJ; bf16_t* O;
    __device__ __forceinline__ void operator()(const f32x4 (&acc)[2][2][4][2], const Unit& u, int wr, int wc, int fr, int fq) const {
        const int row0 = u.pm * BM + wr * 64 + fr, col0 = u.pn * BM + wc * 32 + 8 * fq;
#pragma unroll
        for (int ai = 0; ai < 2; ++ai)
#pragma unroll
            for (int mp = 0; mp < 4; mp += 2) {
                u32x4 yv[2][2], gv[2][2];
#pragma unroll
                for (int mm = 0; mm < 2; ++mm) { const size_t row = (size_t)(row0 + ai * HALF + (mp + mm) * 16);
#pragma unroll
                    for (int bj = 0; bj < 2; ++bj) { const int c = col0 + bj * HALF; yv[mm][bj] = *(const u32x4*)(Y1 + row * 1024 + c); gv[mm][bj] = *(const u32x4*)(PROJ + row * 2048 + 1024 + c); } }
                asm volatile("" ::: "memory");
#pragma unroll
                for (int mm = 0; mm < 2; ++mm) { const int m = mp + mm; const size_t row = (size_t)(row0 + ai * HALF + m * 16);
#pragma unroll
                    for (int bj = 0; bj < 2; ++bj) { const int c = col0 + bj * HALF;
                        float r[8];
#pragma unroll
                        for (int e = 0; e < 8; ++e) { const float a = (e < 4) ? acc[ai][bj][m][0][e] : acc[ai][bj][m][1][e - 4];
                            const unsigned yw = yv[mm][bj][e >> 1], gw = gv[mm][bj][e >> 1]; const float y = (e & 1) ? __uint_as_float(yw & 0xffff0000u) : __uint_as_float(yw << 16);
                            const float g = (e & 1) ? __uint_as_float(gw & 0xffff0000u) : __uint_as_float(gw << 16);
                            r[e] = y / (1.0f + __expf(-a)) * (g / (1.0f + __expf(-g))); }
                        u32x4 w; w.x = cvt_pk_bf16(r[0], r[1]); w.y = cvt_pk_bf16(r[2], r[3]); w.z = cvt_pk_bf16(r[4], r[5]); w.w = cvt_pk_bf16(r[6], r[7]);
                        *(u32x4*)(O + row * 1024 + c) = w; } } }
    }
};
template <bool F32OUT, bool AFF, bool STATS> struct EpiResidB {
    static constexpr bool PERM = true, AFTER_DRAIN = false;
    const bf16_t* X; bf16_t* Z; float* ZF; const float* S1p; const float* S2p; const float* g; const float* b; float* S1n; float* S2n;
    __device__ __forceinline__ void operator()(const f32x4 (&acc)[2][2][4][2], const Unit& u, int wr, int wc, int fr, int fq) const {
        const int row0 = u.pm * BM + wr * 64 + fr, col0 = u.pn * BM + wc * 32 + 8 * fq;
        f32x4 gv[2][2], bv[2][2];
        if (AFF) {
#pragma unroll
            for (int bj = 0; bj < 2; ++bj)
#pragma unroll
                for (int n = 0; n < 2; ++n) { gv[bj][n] = *(const f32x4*)(g + col0 + bj * HALF + 4 * n); bv[bj][n] = *(const f32x4*)(b + col0 + bj * HALF + 4 * n); }
        }
        float rs1[2][4], rs2[2][4];
#pragma unroll
        for (int ai = 0; ai < 2; ++ai) {
            u32x4 xr[4][2]; float s1r[4], s2r[4];
#pragma unroll
            for (int m = 0; m < 4; ++m) { const int row = row0 + ai * HALF + m * 16; const size_t off = (size_t)row * DM + col0;
                if (AFF) { s1r[m] = S1p[row]; s2r[m] = S2p[row]; }
#pragma unroll
                for (int bj = 0; bj < 2; ++bj) xr[m][bj] = *(const u32x4*)(X + off + bj * HALF); }
            asm volatile("" ::: "memory");
#pragma unroll
            for (int m = 0; m < 4; ++m) { const int row = row0 + ai * HALF + m * 16; const size_t off = (size_t)row * DM + col0;
                float mu = 0.f, rs = 1.f;
                if (AFF) { mu = s1r[m] * (1.0f / DM); rs = 1.0f / sqrtf(fmaxf(s2r[m] * (1.0f / DM) - mu * mu, 0.f) + LN_EPS); }
                float p1 = 0.f, p2 = 0.f;
#pragma unroll
                for (int bj = 0; bj < 2; ++bj) { const u32x4 xv = xr[m][bj];
                    f32x4 x0 = {__uint_as_float(xv[0] << 16), __uint_as_float(xv[0] & 0xffff0000u), __uint_as_float(xv[1] << 16), __uint_as_float(xv[1] & 0xffff0000u)};
                    f32x4 x1 = {__uint_as_float(xv[2] << 16), __uint_as_float(xv[2] & 0xffff0000u), __uint_as_float(xv[3] << 16), __uint_as_float(xv[3] & 0xffff0000u)};
                    if (AFF) { x0 = (x0 - mu) * rs * gv[bj][0] + bv[bj][0]; x1 = (x1 - mu) * rs * gv[bj][1] + bv[bj][1]; }
                    const f32x4 r0 = x0 * ALPHA + acc[ai][bj][m][0], r1 = x1 * ALPHA + acc[ai][bj][m][1];
                    if (STATS) { p1 += ((r0[0] + r0[1]) + (r0[2] + r0[3])) + ((r1[0] + r1[1]) + (r1[2] + r1[3]));
                        p2 += ((r0[0] * r0[0] + r0[1] * r0[1]) + (r0[2] * r0[2] + r0[3] * r0[3])) + ((r1[0] * r1[0] + r1[1] * r1[1]) + (r1[2] * r1[2] + r1[3] * r1[3])); }
                    if (F32OUT) { *(f32x4*)(ZF + off + bj * HALF) = r0; *(f32x4*)(ZF + off + bj * HALF + 4) = r1; }
                    else { u32x4 w; w.x = cvt_pk_bf16(r0[0], r0[1]); w.y = cvt_pk_bf16(r0[2], r0[3]); w.z = cvt_pk_bf16(r1[0], r1[1]); w.w = cvt_pk_bf16(r1[2], r1[3]); *(u32x4*)(Z + off + bj * HALF) = w; } }
                if (STATS) { p1 += __shfl_xor(p1, 16); p2 += __shfl_xor(p2, 16); p1 += __shfl_xor(p1, 32); p2 += __shfl_xor(p2, 32); rs1[ai][m] = p1; rs2[ai][m] = p2; } }
        }
        if (STATS) {
#pragma unroll
            for (int ai = 0; ai < 2; ++ai) { const float a1 = fq == 0 ? rs1[ai][0] : fq == 1 ? rs1[ai][1] : fq == 2 ? rs1[ai][2] : rs1[ai][3], a2 = fq == 0 ? rs2[ai][0] : fq == 1 ? rs2[ai][1] : fq == 2 ? rs2[ai][2] : rs2[ai][3];
                const int row = u.pm * BM + ai * HALF + wr * 64 + fq * 16 + fr;
                const float o1 = unsafeAtomicAdd(S1n + row, a1), o2 = unsafeAtomicAdd(S2n + row, a2);
                asm volatile("" :: "v"(o1), "v"(o2)); }
        }
    }
};
}

__device__ __forceinline__ void ln_phase(Frame& F, const float* Z, float* xf, bf16* XB, const float* g, const float* b) {
    const int gw = F.vcu * NWAVES + F.wave, NGW = F.G * NWAVES;
    for (int m = gw; m < M; m += NGW) {
        const GAS f32x4* zr = (const GAS f32x4*)(Z + (size_t)m * DM);
        f32x4 v[8]; float s = 0.f;
#pragma unroll
        for (int j = 0; j < 8; ++j) { v[j] = zr[(j >> 1) * 128 + F.lane * 2 + (j & 1)]; s += (v[j].x + v[j].y) + (v[j].z + v[j].w); }
        const float mean = wave_sum(s) * (1.f / DM); float s2 = 0.f;
#pragma unroll
        for (int j = 0; j < 8; ++j) { v[j] = v[j] - mean; s2 += (v[j].x * v[j].x + v[j].y * v[j].y) + (v[j].z * v[j].z + v[j].w * v[j].w); }
        const float rstd = 1.f / sqrtf(wave_sum(s2) * (1.f / DM) + LN_EPS);
        GAS f32x4* xr = (GAS f32x4*)(xf + (size_t)m * DM);
#pragma unroll
        for (int j = 0; j < 4; ++j) { const int c4 = j * 128 + F.lane * 2;
            const f32x4 g0 = *(const GAS f32x4*)(g + 4 * c4), g1 = *(const GAS f32x4*)(g + 4 * c4 + 4), b0 = *(const GAS f32x4*)(b + 4 * c4), b1 = *(const GAS f32x4*)(b + 4 * c4 + 4);
            const f32x4 o0 = v[2 * j] * rstd * g0 + b0, o1 = v[2 * j + 1] * rstd * g1 + b1;
            xr[c4] = o0; xr[c4 + 1] = o1;
            v4u o; o.x = pk2(o0.x, o0.y); o.y = pk2(o0.z, o0.w); o.z = pk2(o1.x, o1.y); o.w = pk2(o1.z, o1.w); *(GAS v4u*)(XB + (size_t)m * DM + 4 * c4) = o; }
    }
}

__device__ __forceinline__ void ln_phase_b(Frame& F, bf16* XB, const float* g, const float* b) {
    const int gw = F.vcu * NWAVES + F.wave, NGW = F.G * NWAVES;
    f32x4 gg[8], bb[8];
#pragma unroll
    for (int j = 0; j < 4; ++j) { const int c = (j * 64 + F.lane) * 8; gg[2 * j] = *(const GAS f32x4*)(g + c); gg[2 * j + 1] = *(const GAS f32x4*)(g + c + 4); bb[2 * j] = *(const GAS f32x4*)(b + c); bb[2 * j + 1] = *(const GAS f32x4*)(b + c + 4); }
    for (int m0 = 2 * gw; m0 < M; m0 += 2 * NGW) {
        v4u raw[2][4];
#pragma unroll
        for (int r = 0; r < 2; ++r)
#pragma unroll
            for (int j = 0; j < 4; ++j) raw[r][j] = *(const GAS v4u*)(XB + (size_t)(m0 + r) * DM + (j * 64 + F.lane) * 8);
#pragma unroll
        for (int r = 0; r < 2; ++r) {
            f32x4 v[8]; float s = 0.f;
#pragma unroll
            for (int j = 0; j < 4; ++j) { const v4u w = raw[r][j]; v[2 * j] = (f32x4){bflo(w.x), bfhi(w.x), bflo(w.y), bfhi(w.y)}; v[2 * j + 1] = (f32x4){bflo(w.z), bfhi(w.z), bflo(w.w), bfhi(w.w)};
                s += (v[2 * j].x + v[2 * j].y) + (v[2 * j].z + v[2 * j].w) + (v[2 * j + 1].x + v[2 * j + 1].y) + (v[2 * j + 1].z + v[2 * j + 1].w); }
            const float mean = wave_sum(s) * (1.f / DM); float s2 = 0.f;
#pragma unroll
            for (int j = 0; j < 8; ++j) { v[j] = v[j] - mean; s2 += (v[j].x * v[j].x + v[j].y * v[j].y) + (v[j].z * v[j].z + v[j].w * v[j].w); }
            const float rstd = 1.f / sqrtf(wave_sum(s2) * (1.f / DM) + LN_EPS);
#pragma unroll
            for (int j = 0; j < 4; ++j) { const f32x4 o0 = v[2 * j] * rstd * gg[2 * j] + bb[2 * j], o1 = v[2 * j + 1] * rstd * gg[2 * j + 1] + bb[2 * j + 1];
                v4u o; o.x = pk2(o0.x, o0.y); o.y = pk2(o0.z, o0.w); o.z = pk2(o1.x, o1.y); o.w = pk2(o1.z, o1.w); *(GAS v4u*)(XB + (size_t)(m0 + r) * DM + (j * 64 + F.lane) * 8) = o; }
        }
    }
}
__device__ __forceinline__ void ln_phase_final(Frame& F, const bf16* Z, const float* S1, const float* S2, float* out, const float* g, const float* b, int m_lo, int m_hi, int gw, int NGW) {
    f32x4 gg[8], bb[8];
#pragma unroll
    for (int j = 0; j < 4; ++j) { const int c = (j * 64 + F.lane) * 8; gg[2 * j] = *(const GAS f32x4*)(g + c); gg[2 * j + 1] = *(const GAS f32x4*)(g + c + 4); bb[2 * j] = *(const GAS f32x4*)(b + c); bb[2 * j + 1] = *(const GAS f32x4*)(b + c + 4); }
    for (int m0 = m_lo + 2 * gw; m0 < m_hi; m0 += 2 * NGW) {
        v4u raw[2][4]; float mu[2], rs[2];
#pragma unroll
        for (int r = 0; r < 2; ++r) {
#pragma unroll
            for (int j = 0; j < 4; ++j) raw[r][j] = *(const GAS v4u*)(Z + (size_t)(m0 + r) * DM + (j * 64 + F.lane) * 8);
            const float s1 = S1[m0 + r], s2 = S2[m0 + r]; mu[r] = s1 * (1.0f / DM); rs[r] = 1.0f / sqrtf(fmaxf(s2 * (1.0f / DM) - mu[r] * mu[r], 0.f) + LN_EPS); }
#pragma unroll
        for (int r = 0; r < 2; ++r)
#pragma unroll
            for (int j = 0; j < 4; ++j) { const v4u w = raw[r][j];
                const f32x4 v0 = {bflo(w.x), bfhi(w.x), bflo(w.y), bfhi(w.y)}, v1 = {bflo(w.z), bfhi(w.z), bflo(w.w), bfhi(w.w)};
                GAS f32x4* o = (GAS f32x4*)(out + (size_t)(m0 + r) * DM + (j * 64 + F.lane) * 8);
                o[0] = (v0 - mu[r]) * rs[r] * gg[2 * j] + bb[2 * j]; o[1] = (v1 - mu[r]) * rs[r] * gg[2 * j + 1] + bb[2 * j + 1]; }
    }
}
__device__ __forceinline__ float tr_reduce16(const float (&v)[16], int lane) {
    float a[8], b[4], c[2];
    const bool b5 = lane & 32, b4 = lane & 16, b3 = lane & 8, b2 = lane & 4;
#pragma unroll
    for (int i = 0; i < 8; ++i) { const float send = b5 ? v[i] : v[i + 8], keep = b5 ? v[i + 8] : v[i]; a[i] = keep + __shfl_xor(send, 32); }
#pragma unroll
    for (int i = 0; i < 4; ++i) { const float send = b4 ? a[i] : a[i + 4], keep = b4 ? a[i + 4] : a[i]; b[i] = keep + __shfl_xor(send, 16); }
#pragma unroll
    for (int i = 0; i < 2; ++i) { const float send = b3 ? b[i] : b[i + 2], keep = b3 ? b[i + 2] : b[i]; c[i] = keep + __shfl_xor(send, 8); }
    const float send = b2 ? c[0] : c[1], keep = b2 ? c[1] : c[0];
    float d = keep + __shfl_xor(send, 4);
    d += __shfl_xor(d, 2); d += __shfl_xor(d, 1);
    return d;
}
template <bool FULL>
__device__ __forceinline__ void s5_block(Frame& F, const Ptrs& P, const bf16* PROJ, bf16* Y1, size_t row0, int T, int g, float& hr, float& hi) {
    LAS float* ub = (LAS float*)(F.lds + RING_OFF + F.wave * 8192);
    LAS float* yb = ub + 1024;
    const int lane = F.lane;
    const float* lam = (const float*)(P.ws + WS_SSMC); const float* BB = lam + 2 * 64 * 64 * 2;
    const int gp = g * 64 + lane;
    const float lr = lam[2 * gp], li = lam[2 * gp + 1];
    float br[16], bi[16];
#pragma unroll
    for (int c = 0; c < 4; ++c) { const f32x4 x = *(const GAS f32x4*)(BB + (size_t)gp * 32 + 4 * c), y = *(const GAS f32x4*)(BB + (size_t)gp * 32 + 16 + 4 * c);
        br[4 * c] = x.x; br[4 * c + 1] = x.y; br[4 * c + 2] = x.z; br[4 * c + 3] = x.w; bi[4 * c] = y.x; bi[4 * c + 1] = y.y; bi[4 * c + 2] = y.z; bi[4 * c + 3] = y.w; }
    float cr[16], ci[16];
    if (FULL) {
#pragma unroll
        for (int c = 0; c < 16; ++c) { cr[c] = P.in[21][(size_t)(g * 16 + c) * 64 + lane]; ci[c] = P.in[22][(size_t)(g * 16 + c) * 64 + lane]; }
    }
    if (lane < T) { const GAS v4u* ur = (const GAS v4u*)(PROJ + (row0 + lane) * 2048 + g * 16); const v4u a = ur[0], b = ur[1];
        LAS f32x4* d = (LAS f32x4*)(ub + lane * 16);
        d[0] = (f32x4){bflo(a.x), bfhi(a.x), bflo(a.y), bfhi(a.y)}; d[1] = (f32x4){bflo(a.z), bfhi(a.z), bflo(a.w), bfhi(a.w)};
        d[2] = (f32x4){bflo(b.x), bfhi(b.x), bflo(b.y), bfhi(b.y)}; d[3] = (f32x4){bflo(b.z), bfhi(b.z), bflo(b.w), bfhi(b.w)}; }
    LDS_WAIT(); asm volatile("" ::: "memory");
    for (int t = 0; t < T; ++t) {
        float u[16];
#pragma unroll
        for (int c = 0; c < 4; ++c) { const f32x4 x = *(const LAS f32x4*)(ub + t * 16 + 4 * c); u[4 * c] = x.x; u[4 * c + 1] = x.y; u[4 * c + 2] = x.z; u[4 * c + 3] = x.w; }
        float bur = 0.f, bui = 0.f;
#pragma unroll
        for (int c = 0; c < 16; ++c) { bur += u[c] * br[c]; bui += u[c] * bi[c]; }
        const float nr = lr * hr - li * hi + bur, ni = lr * hi + li * hr + bui;
        hr = nr; hi = ni;
        if (FULL) {
            float v[16];
#pragma unroll
            for (int c = 0; c < 16; ++c) v[c] = hr * cr[c] - hi * ci[c];
            const float y = tr_reduce16(v, lane);
            if ((lane & 3) == 0) yb[t * 16 + (((lane >> 5) & 1) * 8 + ((lane >> 4) & 1) * 4 + ((lane >> 3) & 1) * 2 + ((lane >> 2) & 1))] = y;
        }
    }
    if (FULL) {
        LDS_WAIT(); asm volatile("" ::: "memory");
        if (lane < T) {
            float r[16];
#pragma unroll
            for (int c = 0; c < 16; ++c) { const float y = yb[lane * 16 + c] + P.in[23][g * 16 + c] * ub[lane * 16 + c]; r[c] = gelu_tanh_f(y); }
            v4u a, b; a.x = pk2(r[0], r[1]); a.y = pk2(r[2], r[3]); a.z = pk2(r[4], r[5]); a.w = pk2(r[6], r[7]); b.x = pk2(r[8], r[9]); b.y = pk2(r[10], r[11]); b.z = pk2(r[12], r[13]); b.w = pk2(r[14], r[15]);
            GAS v4u* o = (GAS v4u*)(Y1 + (row0 + lane) * 1024 + g * 16); o[0] = a; o[1] = b;
        }
    }
    LDS_WAIT(); asm volatile("" ::: "memory");
}
__device__ __forceinline__ void s5_local(Frame& F, const Ptrs& P, const bf16* PROJ) {
    float* SEND = (float*)(P.ws + WS_SEND);
    for (int i = 0;; ++i) { const int item = (i * F.G + F.vcu) * NWAVES + F.wave; if (item >= 2 * 256 * 64) break;
        const int g = item & 63, bc = item >> 6;
        float hr = 0.f, hi = 0.f;
        s5_block<false>(F, P, PROJ, nullptr, (size_t)bc * 64, 64, g, hr, hi);
        SEND[((size_t)bc * 64 + g) * 128 + F.lane] = hr; SEND[((size_t)bc * 64 + g) * 128 + 64 + F.lane] = hi; }
}
__device__ __forceinline__ void s5_carry(Frame& F, const Ptrs& P) {
    const int gt = F.vcu * (NWAVES * 64) + F.tid;
    if (gt >= 2 * 64 * 64) return;
    const int b = gt >> 12, gp = gt & 4095, g = gp >> 6, p = gp & 63;
    const float* SEND = (const float*)(P.ws + WS_SEND); float* HIN = (float*)(P.ws + WS_HIN);
    const float* lam64 = (const float*)(P.ws + WS_SSMC) + 64 * 64 * 2;
    const float lr = lam64[2 * gp], li = lam64[2 * gp + 1];
    float hr = 0.f, hi = 0.f;
    for (int c0 = 0; c0 < 256; c0 += 8) {
        float sr[8], si[8];
#pragma unroll
        for (int k = 0; k < 8; ++k) { const size_t o = (((size_t)b * 256 + c0 + k) * 64 + g) * 128 + p; sr[k] = SEND[o]; si[k] = SEND[o + 64]; }
#pragma unroll
        for (int k = 0; k < 8; ++k) { const size_t o = (((size_t)b * 256 + c0 + k) * 64 + g) * 128 + p; HIN[o] = hr; HIN[o + 64] = hi;
            const float nr = lr * hr - li * hi + sr[k], ni = lr * hi + li * hr + si[k]; hr = nr; hi = ni; }
    }
    P.out[O_HRP + (size_t)b * 4096 + gp] = hr; P.out[O_HIP + (size_t)b * 4096 + gp] = hi;
}
__device__ __forceinline__ void s5_full(Frame& F, const Ptrs& P, const bf16* PROJ, bf16* Y1) {
    const float* HIN = (const float*)(P.ws + WS_HIN);
    constexpr int NP = 2 * 256 * 64, NS = 32 * 64;
    for (int i = 0;; ++i) { const int item = (i * F.G + F.vcu) * NWAVES + F.wave; if (item >= NP + NS) break;
        if (item < NP) { const int g = item & 63, bc = item >> 6;
            float hr = HIN[((size_t)bc * 64 + g) * 128 + F.lane], hi = HIN[((size_t)bc * 64 + g) * 128 + 64 + F.lane];
            s5_block<true>(F, P, PROJ, Y1, (size_t)bc * 64, 64, g, hr, hi);
        } else { const int it = item - NP, g = it & 63, b = it >> 6;
            float hr = P.in[6][((size_t)b * 64 + g) * 64 + F.lane], hi = P.in[7][((size_t)b * 64 + g) * 64 + F.lane];
            s5_block<true>(F, P, PROJ, Y1, (size_t)MP + b * 32, 32, g, hr, hi);
            P.out[O_HRS + ((size_t)b * 64 + g) * 64 + F.lane] = hr; P.out[O_HIS + ((size_t)b * 64 + g) * 64 + F.lane] = hi; }
    }
}


__device__ __forceinline__ int opq(int x) { asm volatile("" : "+v"(x)); return x; }
typedef short s16x4 __attribute__((ext_vector_type(4)));
typedef unsigned u32x2v __attribute__((ext_vector_type(2)));
typedef short v4i16_t __attribute__((ext_vector_type(4)));
typedef float f32x16 __attribute__((ext_vector_type(16)));
typedef __bf16 bf16x2_t __attribute__((ext_vector_type(2)));
__device__ __forceinline__ unsigned cvtpk(float lo, float hi) { f32x2v v = {lo, hi}; bf16x2_t b = __builtin_convertvector(v, bf16x2_t); return __builtin_bit_cast(unsigned, b); }
__device__ __forceinline__ s16x4 vtr(const LAS unsigned char* p) { return __builtin_bit_cast(s16x4, __builtin_amdgcn_ds_read_tr16_b64_v4i16((LAS v4i16_t*)p)); }
__device__ __forceinline__ bf16x8 vtr2(const LAS unsigned char* p0, const LAS unsigned char* p1) { const s16x4 lo = vtr(p0), hi = vtr(p1); return __builtin_shufflevector(lo, hi, 0, 1, 2, 3, 4, 5, 6, 7); }
__device__ __forceinline__ unsigned off128(unsigned row, unsigned ch) { return 256u * row + 16u * (ch ^ (((row & 3) << 2) | ((row >> 2) & 3))); }
__device__ __forceinline__ unsigned off64(unsigned row, unsigned ch) { const unsigned a = row >> 1; return 128u * row + 16u * (ch ^ (((a & 1) << 2) | ((a >> 1) & 3))); }
#define MFMA32(a, b, c) __builtin_amdgcn_mfma_f32_32x32x16_bf16((a), (b), (c), 0, 0, 0)
__device__ __forceinline__ v4u pack8(const f32x4 a, const f32x4 b) { v4u o; o.x = cvtpk(a.x, a.y); o.y = cvtpk(a.z, a.w); o.z = cvtpk(b.x, b.y); o.w = cvtpk(b.z, b.w); return o; }

__device__ __forceinline__ void glds16(const void* gsrc, unsigned lds_dst) { unsigned keep;
    asm volatile("s_mov_b32 %0, m0\n\ts_mov_b32 m0, %2\n\ts_nop 0\n\tglobal_load_lds_dwordx4 %1, off\n\ts_mov_b32 m0, %0" : "=&s"(keep) : "v"(gsrc), "s"(lds_dst) : "memory"); }
#define GLDS16(gptr, ldsptr) glds16((const void*)(gptr), (unsigned)(size_t)(ldsptr))
__device__ __forceinline__ void glds16s(const void* sbase, unsigned voff, unsigned lds_dst) { unsigned keep;
    asm volatile("s_mov_b32 %0, m0\n\ts_mov_b32 m0, %3\n\ts_nop 4\n\tglobal_load_lds_dwordx4 %1, %2\n\ts_mov_b32 m0, %0" : "=&s"(keep) : "v"(voff), "s"(sbase), "s"(lds_dst) : "memory"); }
#define VMW(n) asm volatile("s_waitcnt vmcnt(" #n ")" ::: "memory")
#define LGW0() asm volatile("s_waitcnt lgkmcnt(0)" ::: "memory")
#define SCHEDB() __builtin_amdgcn_sched_barrier(0)
__device__ __forceinline__ float silu_fast(float g) { return g * __builtin_amdgcn_rcpf(1.0f + __builtin_amdgcn_exp2f(-1.4426950408889634f * g)); }
__device__ __forceinline__ void sb_tile_weights(const f32x16& s, int lane, bool diag, float& later, bf16x8& p0, bf16x8& p1) {
    const int j = lane & 31, h = lane >> 5;
    const int lim = diag ? j : 64;
    float l[16];
#pragma unroll
    for (int r = 0; r < 16; ++r) { const int kk = (r & 3) + 8 * (r >> 2) + 4 * h; const float z = s[r];
        const float sp = fmaxf(z, 0.f) + __builtin_amdgcn_logf(1.0f + __builtin_amdgcn_exp2f(-fabsf(z))); l[r] = (kk < lim) ? -sp : 0.f; }
    float A[4], PA[4];
#pragma unroll
    for (int g = 0; g < 4; ++g) { l[4 * g + 2] += l[4 * g + 3]; l[4 * g + 1] += l[4 * g + 2]; l[4 * g] += l[4 * g + 1]; A[g] = l[4 * g]; PA[g] = __shfl_xor(A[g], 32); }
    float T[4]; T[3] = 0.f; T[2] = A[3] + PA[3]; T[1] = T[2] + A[2] + PA[2]; T[0] = T[1] + A[1] + PA[1];
    const float total = T[0] + A[0] + PA[0];
    unsigned pw[8];
#pragma unroll
    for (int g = 0; g < 4; ++g) { const float base = later + T[g] + (h == 0 ? PA[g] : 0.f); float w[4];
#pragma unroll
        for (int e = 0; e < 4; ++e) { const int r = 4 * g + e; const int kk = e + 8 * g + 4 * h; w[e] = (kk < lim) ? __builtin_amdgcn_exp2f(s[r] + l[r] + base) : 0.f; }
        pw[2 * g] = cvtpk(w[0], w[1]); pw[2 * g + 1] = cvtpk(w[2], w[3]); }
    later += total;
    p0 = __builtin_bit_cast(bf16x8, (v4u){pw[0], pw[1], pw[2], pw[3]}); p1 = __builtin_bit_cast(bf16x8, (v4u){pw[4], pw[5], pw[6], pw[7]});
}
__device__ __forceinline__ void sb_tile_pv(const LAS unsigned char* Vimg, int lane, const bf16x8& p0, const bf16x8& p1, f32x16 (&o)[4]) {
    const int h = lane >> 5, blk = (lane >> 4) & 1, q4 = (lane & 15) >> 2, p4 = lane & 3;
#pragma unroll
    for (int c = 0; c < 4; ++c) {
        const unsigned a0 = off128(4 * h + q4, 4 * c + 2 * blk + (p4 >> 1)) + 8 * (p4 & 1), a1 = off128(8 + 4 * h + q4, 4 * c + 2 * blk + (p4 >> 1)) + 8 * (p4 & 1);
        const bf16x8 v0 = vtr2(Vimg + a0, Vimg + a1), v1 = vtr2(Vimg + a0 + 4096, Vimg + a1 + 4096);
        o[c] = MFMA32(v0, p0, o[c]); o[c] = MFMA32(v1, p1, o[c]); }
}
typedef __amdgpu_buffer_rsrc_t rsrc_t;
__device__ __forceinline__ rsrc_t mk_rsrc(const void* p) { return __builtin_amdgcn_make_buffer_rsrc((void*)p, (short)0, 0x7fffffff, 0x00020000); }
__device__ __forceinline__ void dma_tile128(LAS unsigned char* img, const char* tilebase, const unsigned (&voff)[4]) {
#pragma unroll
    for (int i = 0; i < 8; ++i) glds16s(tilebase + (size_t)i * 32768, voff[i & 3], (unsigned)(size_t)(img + i * 1024));
}
template <bool sample>
__device__ __forceinline__ void sb_item(Frame& F, const bf16* PROJ, const float* cache_k, const float* cache_v, bf16* AO, const int b, const int hh, const int kt0, const size_t m0) {
    LAS unsigned char* Kimg = F.lds + RING_OFF + F.wave * 16384;
    LAS unsigned char* Vimg = Kimg + 8192;
    const int lane = F.lane, j = lane & 31, h = lane >> 5;
    const int srow = lane >> 4, sch = lane & 15;
    unsigned voff[4];
#pragma unroll
    for (int v = 0; v < 4; ++v) voff[v] = (unsigned)srow * 8192u + (unsigned)((sch ^ (srow << 2)) ^ v) * 16u;
    const rsrc_t rsO = mk_rsrc(AO), rsCK = mk_rsrc(cache_k), rsCV = mk_rsrc(cache_v);
    const unsigned vso = (unsigned)(srow * 1024 + sch * 8) * 2u, vsc = (unsigned)(srow * 1024 + sch * 8) * 4u;
    {
        const char* qb = (const char*)(PROJ + m0 * 4096 + hh * 128);
        const char* kvb = (const char*)(PROJ + (sample ? m0 : (size_t)b * SEQ) * 4096 + 1024 + hh * 128);
        LGW0();
        dma_tile128(Vimg, qb, voff);
        dma_tile128(Kimg, kvb + (sample ? 0 : (size_t)kt0 * 262144), voff);
        VMW(8);
        bf16x8 qf[8];
#pragma unroll
        for (int ks = 0; ks < 8; ++ks) qf[ks] = *(const LAS bf16x8*)(Vimg + off128(j, 2 * ks + h));
        LGW0(); SCHEDB();
        dma_tile128(Vimg, kvb + (sample ? 0 : (size_t)kt0 * 262144) + 2048, voff);
        f32x16 o[4];
#pragma unroll
        for (int c = 0; c < 4; ++c)
#pragma unroll
            for (int r = 0; r < 16; ++r) o[c][r] = 0.f;
        float later = 0.f;
        for (int kt = kt0; kt >= 0; --kt) {
            const bool diag = (kt == kt0);
            if (sample && !diag) {
                const unsigned cbu = ((((unsigned)b * PAST + 32u * (unsigned)kt) * 8u + (unsigned)hh) * 128u) * 4u;
                LGW0();
                { f32x4 t0[8], t1[8];
#pragma unroll
                  for (int i = 0; i < 8; ++i) { t0[i] = __builtin_bit_cast(f32x4, __builtin_amdgcn_raw_buffer_load_b128(rsCK, (int)vsc, (int)(cbu + i * 16384), 0)); t1[i] = __builtin_bit_cast(f32x4, __builtin_amdgcn_raw_buffer_load_b128(rsCK, (int)vsc, (int)(cbu + i * 16384 + 16), 0)); }
#pragma unroll
                  for (int i = 0; i < 8; ++i) *(LAS v4u*)(Kimg + off128(srow + 4 * i, sch)) = pack8(t0[i], t1[i]); }
                { f32x4 t0[8], t1[8];
#pragma unroll
                  for (int i = 0; i < 8; ++i) { t0[i] = __builtin_bit_cast(f32x4, __builtin_amdgcn_raw_buffer_load_b128(rsCV, (int)vsc, (int)(cbu + i * 16384), 0)); t1[i] = __builtin_bit_cast(f32x4, __builtin_amdgcn_raw_buffer_load_b128(rsCV, (int)vsc, (int)(cbu + i * 16384 + 16), 0)); }
#pragma unroll
                  for (int i = 0; i < 8; ++i) *(LAS v4u*)(Vimg + off128(srow + 4 * i, sch)) = pack8(t0[i], t1[i]); }
                LGW0();
            } else {
                if (sample) VMW(0); else VMW(8);
            }
            SCHEDB();
            bf16x8 kf[8];
#pragma unroll
            for (int ks = 0; ks < 8; ++ks) kf[ks] = *(const LAS bf16x8*)(Kimg + off128(j, 2 * ks + h));
            f32x16 s;
#pragma unroll
            for (int r = 0; r < 16; ++r) s[r] = 0.f;
#pragma unroll
            for (int ks = 0; ks < 8; ++ks) s = MFMA32(kf[ks], qf[ks], s);
            if (!sample && kt > 0) { LGW0(); SCHEDB(); dma_tile128(Kimg, kvb + (size_t)(kt - 1) * 262144, voff); SCHEDB(); }
            bf16x8 p0, p1;
            sb_tile_weights(s, lane, diag, later, p0, p1);
            if (!sample) { if (kt > 0) VMW(8); else VMW(0); }
            SCHEDB();
            sb_tile_pv(Vimg, lane, p0, p1, o);
            if (__all(later < SB_CUT2)) break;
            if (!sample && kt > 0) { LGW0(); SCHEDB(); dma_tile128(Vimg, kvb + (size_t)(kt - 1) * 262144 + 2048, voff); SCHEDB(); }
        }
        VMW(0); LGW0(); SCHEDB();
        dma_tile128(Kimg, qb + 6144, voff);
        VMW(0); SCHEDB();
#pragma unroll
        for (int c = 0; c < 4; ++c)
#pragma unroll
            for (int g = 0; g < 4; ++g) { const unsigned a = off128(j, 4 * c + g) + 8 * h; const u32x2v gv = *(const LAS u32x2v*)(Kimg + a);
                u32x2v ov; ov.x = cvtpk(o[c][4 * g] * silu_fast(bflo(gv.x)), o[c][4 * g + 1] * silu_fast(bfhi(gv.x))); ov.y = cvtpk(o[c][4 * g + 2] * silu_fast(bflo(gv.y)), o[c][4 * g + 3] * silu_fast(bfhi(gv.y)));
                *(LAS u32x2v*)(Vimg + a) = ov; }
        LGW0();
        { const unsigned ob = ((unsigned)m0 * 1024u + (unsigned)hh * 128u) * 2u;
#pragma unroll
          for (int i = 0; i < 8; ++i) { const v4u x = *(const LAS v4u*)(Vimg + off128(srow + 4 * i, sch)); __builtin_amdgcn_raw_buffer_store_b128(x, rsO, (int)vso, (int)(ob + i * 8192), 0); } }
    }
}
__device__ __forceinline__ void sb_attn_mfma(Frame& F, const bf16* PROJ, const float* cache_k, const float* cache_v, bf16* AO, int ctr_word) {
    if (F.G == 256) {
        LAS unsigned* ctr = (LAS unsigned*)(F.lds + MISC_OFF) + ctr_word;
        for (;;) {
            int it = 0; if (F.lane == 0) it = (int)__hip_atomic_fetch_add(ctr, 1u, __ATOMIC_RELAXED, __HIP_MEMORY_SCOPE_WORKGROUP);
            it = __builtin_amdgcn_readfirstlane(it);
            if (it > 32) break;
            if (it == 0) { const int b = F.vcu >> 3, hh = F.vcu & 7; sb_item<true>(F, PROJ, cache_k, cache_v, AO, b, hh, 64, (size_t)MP + b * 32); }
            else { const int bh = ((F.vcu >> 4) + (it - 1)) & 15, qt = (32 - it) * 16 + (F.vcu & 15);
                sb_item<false>(F, PROJ, cache_k, cache_v, AO, bh >> 3, bh & 7, qt, (size_t)(bh >> 3) * SEQ + 32 * qt); }
        }
    } else {
        const int gw = F.vcu * NWAVES + F.wave, NGW = F.G * NWAVES;
        for (int item = gw; item < 256; item += NGW) { const int b = item >> 3, hh = item & 7; sb_item<true>(F, PROJ, cache_k, cache_v, AO, b, hh, 64, (size_t)MP + b * 32); }
        for (int item = gw; item < 2 * 8 * 512; item += NGW) { const int qt = item & 511, bh = item >> 9; sb_item<false>(F, PROJ, cache_k, cache_v, AO, bh >> 3, bh & 7, qt, (size_t)(bh >> 3) * SEQ + 32 * qt); }
    }
}

__device__ __forceinline__ void swa_tile(const LAS unsigned char* Kimg, const LAS unsigned char* Vimg, int kt, bool sample, float slope2, const float (&cr)[16], int lane,
                                         const bf16x8 (&qf)[2][4], f32x16 (&o)[2][2], float (&mrun)[2], float (&lsum)[2]) {
    const int j = lane & 31, h = lane >> 5, blk = (lane >> 4) & 1, q4 = (lane & 15) >> 2, p4 = lane & 3;
    bf16x8 kf[4];
#pragma unroll
    for (int ks = 0; ks < 4; ++ks) kf[ks] = *(const LAS bf16x8*)(Kimg + off64(j, 2 * ks + h));
    bf16x8 vf[2][2];
#pragma unroll
    for (int c = 0; c < 2; ++c)
#pragma unroll
        for (int k2 = 0; k2 < 2; ++k2) { const unsigned a0 = off64(16 * k2 + 4 * h + q4, 4 * c + 2 * blk + (p4 >> 1)) + 8 * (p4 & 1), a1 = off64(16 * k2 + 8 + 4 * h + q4, 4 * c + 2 * blk + (p4 >> 1)) + 8 * (p4 & 1);
            vf[c][k2] = vtr2(Vimg + a0, Vimg + a1); }
    const float A0 = -slope2 * (float)(128 + j - 32 * kt - 4 * h), A1 = sample ? A0 : A0 - 32.0f * slope2;
    f32x16 s0, s1;
#pragma unroll
    for (int r = 0; r < 16; ++r) { const float t0 = A0 + cr[r], t1 = A1 + cr[r]; s0[r] = fminf(t0, -t0); s1[r] = fminf(t1, -t1); }
#pragma unroll
    for (int ks = 0; ks < 4; ++ks) { s0 = MFMA32(kf[ks], qf[0][ks], s0); s1 = MFMA32(kf[ks], qf[1][ks], s1); }
    float mx0 = fmaxf(fmaxf(fmaxf(s0[0], s0[1]), fmaxf(s0[2], s0[3])), fmaxf(fmaxf(s0[4], s0[5]), fmaxf(s0[6], s0[7])));
    float mx1 = fmaxf(fmaxf(fmaxf(s1[0], s1[1]), fmaxf(s1[2], s1[3])), fmaxf(fmaxf(s1[4], s1[5]), fmaxf(s1[6], s1[7])));
    mx0 = fmaxf(mx0, fmaxf(fmaxf(fmaxf(s0[8], s0[9]), fmaxf(s0[10], s0[11])), fmaxf(fmaxf(s0[12], s0[13]), fmaxf(s0[14], s0[15]))));
    mx1 = fmaxf(mx1, fmaxf(fmaxf(fmaxf(s1[8], s1[9]), fmaxf(s1[10], s1[11])), fmaxf(fmaxf(s1[12], s1[13]), fmaxf(s1[14], s1[15]))));
    mx0 = fmaxf(mx0, __shfl_xor(mx0, 32)); mx1 = fmaxf(mx1, __shfl_xor(mx1, 32));
    if (__any((mx0 > mrun[0]) || (mx1 > mrun[1]))) {
        const float n0 = fmaxf(mrun[0], mx0), n1 = fmaxf(mrun[1], mx1), f0 = __builtin_amdgcn_exp2f(mrun[0] - n0), f1 = __builtin_amdgcn_exp2f(mrun[1] - n1);
        mrun[0] = n0; mrun[1] = n1; lsum[0] *= f0; lsum[1] *= f1;
#pragma unroll
        for (int c = 0; c < 2; ++c)
#pragma unroll
            for (int r = 0; r < 16; ++r) { o[0][c][r] *= f0; o[1][c][r] *= f1; }
    }
    const float m0 = mrun[0], m1 = mrun[1];
    float ps0 = 0.f, ps1 = 0.f; unsigned pw0[8], pw1[8];
#pragma unroll
    for (int g = 0; g < 8; ++g) { const float e0 = __builtin_amdgcn_exp2f(s0[2 * g] - m0), e1 = __builtin_amdgcn_exp2f(s0[2 * g + 1] - m0), e2 = __builtin_amdgcn_exp2f(s1[2 * g] - m1), e3 = __builtin_amdgcn_exp2f(s1[2 * g + 1] - m1);
        ps0 += e0 + e1; ps1 += e2 + e3; pw0[g] = cvtpk(e0, e1); pw1[g] = cvtpk(e2, e3); }
    lsum[0] += ps0; lsum[1] += ps1;
    const bf16x8 p00 = __builtin_bit_cast(bf16x8, (v4u){pw0[0], pw0[1], pw0[2], pw0[3]}), p01 = __builtin_bit_cast(bf16x8, (v4u){pw0[4], pw0[5], pw0[6], pw0[7]});
    const bf16x8 p10 = __builtin_bit_cast(bf16x8, (v4u){pw1[0], pw1[1], pw1[2], pw1[3]}), p11 = __builtin_bit_cast(bf16x8, (v4u){pw1[4], pw1[5], pw1[6], pw1[7]});
#pragma unroll
    for (int c = 0; c < 2; ++c) { o[0][c] = MFMA32(vf[c][0], p00, o[0][c]); o[1][c] = MFMA32(vf[c][0], p10, o[1][c]); o[0][c] = MFMA32(vf[c][1], p01, o[0][c]); o[1][c] = MFMA32(vf[c][1], p11, o[1][c]); }
}
__device__ __forceinline__ void dma_tile64(LAS unsigned char* img, const char* tilebase, const unsigned (&voff)[2]) {
#pragma unroll
    for (int i = 0; i < 4; ++i) glds16s(tilebase + (size_t)i * 73728, voff[i & 1], (unsigned)(size_t)(img + i * 1024));
}
template <bool sample>
__device__ __forceinline__ void swa_attn_mfma_t(Frame& F, const bf16* PROJ, const float* cache_k, const float* cache_v, const float* sinks, bf16* AO) {
    LAS unsigned char* buf = F.lds + RING_OFF + F.wave * 16384;
    const int lane = F.lane, j = lane & 31, h = lane >> 5;
    const int gw = F.vcu * NWAVES + F.wave, NGW = F.G * NWAVES;
    const int srow = lane >> 3, sch = lane & 7;
    unsigned voff[2];
#pragma unroll
    for (int v = 0; v < 2; ++v) voff[v] = (unsigned)srow * 9216u + (unsigned)(sch ^ ((((srow >> 1) & 1) << 2) | ((2 * v + (srow >> 2)) & 3))) * 16u;
    const rsrc_t rsO = mk_rsrc(AO);
    const unsigned vso = (unsigned)(srow * 2048 + sch * 8) * 2u;
    constexpr int NPI = 2 * 256 * 4 * 8;
    for (int item = gw; item < (sample ? 1024 : NPI); item += NGW) {
        int b, c64, kvh, rr; size_t m0; int kt_lo;
        if (!sample) { rr = item & 7; kvh = (item >> 3) & 3; c64 = (item >> 5) & 255; b = item >> 13; m0 = (size_t)b * SEQ + 64 * c64; kt_lo = (c64 >= 2) ? 0 : (4 - 2 * c64); }
        else { rr = item & 7; kvh = (item >> 3) & 3; b = item >> 5; c64 = 0; m0 = (size_t)MP + b * 32; kt_lo = 0; }
        const int hq = kvh * 8 + rr;
        const float slope2 = exp2f(-0.25f * (float)(hq + 1)) * 1.4426950408889634f;
        const float sink = sinks[hq] * 1.4426950408889634f;
        float cr[16];
#pragma unroll
        for (int r = 0; r < 16; ++r) cr[r] = slope2 * (float)((r & 3) + 8 * (r >> 2));
        const char* qb = (const char*)(PROJ + m0 * 4608 + hq * 64);
        LGW0();
        dma_tile64(buf + 8192, qb, voff); dma_tile64(buf + 12288, qb + (sample ? 0 : 294912), voff);
        VMW(0);
        bf16x8 qf[2][4];
#pragma unroll
        for (int qi = 0; qi < 2; ++qi)
#pragma unroll
            for (int ks = 0; ks < 4; ++ks) qf[qi][ks] = *(const LAS bf16x8*)(buf + 8192 + 4096 * qi + off64(j, 2 * ks + h));
        LGW0(); SCHEDB();
        f32x16 o[2][2];
#pragma unroll
        for (int qi = 0; qi < 2; ++qi)
#pragma unroll
            for (int c = 0; c < 2; ++c)
#pragma unroll
                for (int r = 0; r < 16; ++r) o[qi][c][r] = 0.f;
        float mrun[2] = {sink, sink}, lsum[2] = {h == 0 ? 1.f : 0.f, h == 0 ? 1.f : 0.f};
        if (!sample) {
            const char* kvb = (const char*)(PROJ + ((size_t)b * SEQ + 64 * (size_t)c64) * 4608 + 2048 + kvh * 64) - (size_t)128 * 9216;
            LGW0();
            dma_tile64(buf, kvb + (size_t)5 * 294912, voff); dma_tile64(buf + 4096, kvb + (size_t)5 * 294912 + 512, voff);
            for (int kt = 5; kt >= kt_lo; --kt) {
                LAS unsigned char* cur = buf + (((5 - kt) & 1) ? 8192 : 0); LAS unsigned char* nxt = buf + (((5 - kt) & 1) ? 0 : 8192);
                if (kt > kt_lo) { LGW0(); SCHEDB(); dma_tile64(nxt, kvb + (size_t)(kt - 1) * 294912, voff); dma_tile64(nxt + 4096, kvb + (size_t)(kt - 1) * 294912 + 512, voff); VMW(8); }
                else VMW(0);
                SCHEDB();
                swa_tile(cur, cur + 4096, kt, false, slope2, cr, lane, qf, o, mrun, lsum);
            }
        } else {
            LAS unsigned char* Kimg = buf; LAS unsigned char* Vimg = buf + 4096;
            for (int kt = 0; kt < 5; ++kt) {
                LGW0();
                if (kt == 4) { const char* kb = (const char*)(PROJ + m0 * 4608 + 2048 + kvh * 64); dma_tile64(Kimg, kb, voff); dma_tile64(Vimg, kb + 512, voff); VMW(0); }
                else {
                    const size_t cb = (((size_t)b * 128 + 32 * kt + srow) * 4 + kvh) * 64 + sch * 8;
#pragma unroll
                    for (int i = 0; i < 4; ++i) { const size_t o8 = cb + (size_t)(8 * i) * 256; const unsigned a = off64(srow + 8 * i, sch);
                        const f32x4 k0 = *(const GAS f32x4*)(cache_k + o8), k1 = *(const GAS f32x4*)(cache_k + o8 + 4), v0 = *(const GAS f32x4*)(cache_v + o8), v1 = *(const GAS f32x4*)(cache_v + o8 + 4);
                        *(LAS v4u*)(Kimg + a) = pack8(k0, k1); *(LAS v4u*)(Vimg + a) = pack8(v0, v1); }
                    LGW0();
                }
                SCHEDB();
                swa_tile(Kimg, Vimg, kt, true, slope2, cr, lane, qf, o, mrun, lsum);
            }
        }
        VMW(0); LGW0(); SCHEDB();
        dma_tile64(buf, qb + 5120, voff); dma_tile64(buf + 4096, qb + 5120 + (sample ? 0 : 294912), voff);
        VMW(0); SCHEDB();
#pragma unroll
        for (int qi = 0; qi < 2; ++qi) {
            const float inv = 1.0f / (lsum[qi] + __shfl_xor(lsum[qi], 32));
#pragma unroll
            for (int c = 0; c < 2; ++c)
#pragma unroll
                for (int g = 0; g < 4; ++g) { const unsigned a = 4096 * qi + off64(j, 4 * c + g) + 8 * h; const u32x2v gv = *(const LAS u32x2v*)(buf + a);
                    u32x2v ov; ov.x = cvtpk(o[qi][c][4 * g] * inv * silu_fast(bflo(gv.x)), o[qi][c][4 * g + 1] * inv * silu_fast(bfhi(gv.x))); ov.y = cvtpk(o[qi][c][4 * g + 2] * inv * silu_fast(bflo(gv.y)), o[qi][c][4 * g + 3] * inv * silu_fast(bfhi(gv.y)));
                    *(LAS u32x2v*)(buf + 8192 + a) = ov; }
        }
        LGW0();
        { const unsigned ob = ((unsigned)m0 * 2048u + (unsigned)hq * 64u) * 2u;
#pragma unroll
          for (int qi = 0; qi < 2; ++qi) {
              if (sample && qi == 1) break;
#pragma unroll
              for (int i = 0; i < 4; ++i) { const v4u x = *(const LAS v4u*)(buf + 8192 + 4096 * qi + off64(srow + 8 * i, sch)); __builtin_amdgcn_raw_buffer_store_b128(x, rsO, (int)vso, (int)(ob + qi * 131072 + i * 32768), 0); } } }
    }
}
#define WG_BAR() asm volatile("s_waitcnt vmcnt(0) lgkmcnt(0)\n\ts_barrier" ::: "memory")
__device__ __forceinline__ void swa_attn_wg(Frame& F, const bf16* PROJ, const float* cache_k, const float* cache_v, const float* sinks, bf16* AO) {
    LAS unsigned char* KV = F.lds + RING_OFF;
    LAS unsigned char* stg = F.lds + RING_OFF + 49152 + F.wave * 8192;
    const int lane = F.lane, j = lane & 31, h = lane >> 5;
    const int srow = lane >> 3, sch = lane & 7;
    unsigned voff[2];
#pragma unroll
    for (int v = 0; v < 2; ++v) voff[v] = (unsigned)srow * 9216u + (unsigned)(sch ^ ((((srow >> 1) & 1) << 2) | ((2 * v + (srow >> 2)) & 3))) * 16u;
    const rsrc_t rsO = mk_rsrc(AO);
    const unsigned vso = (unsigned)(srow * 2048 + sch * 8) * 2u;
    constexpr int NPU = 2 * 256 * 4, NU = NPU + 32 * 4;
    auto fill = [&](int u) {
        if (u < NPU) { const int kvh = u & 3, c64 = (u >> 2) & 255, b = u >> 10, kt_lo = (c64 >= 2) ? 0 : (4 - 2 * c64);
            const char* kvb = (const char*)(PROJ + ((size_t)b * SEQ + 64 * (size_t)c64) * 4608 + 2048 + kvh * 64) - (size_t)128 * 9216;
#pragma unroll
            for (int i = 0; i < 6; ++i) { const int p = F.wave * 6 + i, kt = p >> 3, w8 = p & 7;
                if (kt >= kt_lo) glds16s(kvb + (size_t)kt * 294912 + (w8 >> 2) * 512 + (size_t)(w8 & 3) * 73728, voff[w8 & 1], (unsigned)(size_t)(KV + kt * 8192 + (w8 >> 2) * 4096 + (w8 & 3) * 1024)); }
        } else { const int su = u - NPU, kvh = su & 3, b = su >> 2;
            if (F.wave < 2) { const char* kb = (const char*)(PROJ + ((size_t)MP + b * 32) * 4608 + 2048 + kvh * 64) + F.wave * 512;
#pragma unroll
                for (int i = 0; i < 4; ++i) glds16s(kb + (size_t)i * 73728, voff[i & 1], (unsigned)(size_t)(KV + 4 * 8192 + F.wave * 4096 + i * 1024)); }
#pragma unroll
            for (int i = 0; i < 4; ++i) { const int ci = F.tid + 512 * i, kvsel = ci >> 10, cc = ci & 1023, kt = cc >> 8, row = (cc >> 3) & 31, ch = cc & 7;
                const float* src = (kvsel ? cache_v : cache_k) + (((size_t)b * 128 + 32 * kt + row) * 4 + kvh) * 64 + ch * 8;
                const f32x4 x0 = *(const GAS f32x4*)src, x1 = *(const GAS f32x4*)(src + 4);
                *(LAS v4u*)(KV + kt * 8192 + kvsel * 4096 + off64(row, ch)) = pack8(x0, x1); }
        }
    };
    auto qfill = [&](int u) {
        size_t m0; int hq; bool sample = u >= NPU;
        if (!sample) { const int kvh = u & 3, c64 = (u >> 2) & 255, b = u >> 10; m0 = (size_t)b * SEQ + 64 * c64; hq = kvh * 8 + F.wave; }
        else { const int su = u - NPU, kvh = su & 3, b = su >> 2; m0 = (size_t)MP + b * 32; hq = kvh * 8 + F.wave; }
        const char* qb = (const char*)(PROJ + m0 * 4608 + hq * 64);
        dma_tile64(stg, qb, voff); dma_tile64(stg + 4096, qb + (sample ? 0 : 294912), voff);
    };
    int u = F.vcu;
    if (u < NU) { fill(u); qfill(u); }
    for (; u < NU; u += F.G) {
        const bool sample = u >= NPU;
        int kvh, c64, b; size_t m0; int kt_lo, kt_hi;
        if (!sample) { kvh = u & 3; c64 = (u >> 2) & 255; b = u >> 10; m0 = (size_t)b * SEQ + 64 * c64; kt_lo = (c64 >= 2) ? 0 : (4 - 2 * c64); kt_hi = 5; }
        else { const int su = u - NPU; kvh = su & 3; b = su >> 2; c64 = 0; m0 = (size_t)MP + b * 32; kt_lo = 0; kt_hi = 4; }
        const int hq = kvh * 8 + F.wave;
        const float slope2 = exp2f(-0.25f * (float)(hq + 1)) * 1.4426950408889634f;
        const float sink = sinks[hq] * 1.4426950408889634f;
        float cr[16];
#pragma unroll
        for (int r = 0; r < 16; ++r) cr[r] = slope2 * (float)((r & 3) + 8 * (r >> 2));
        WG_BAR();
        bf16x8 qf[2][4];
#pragma unroll
        for (int qi = 0; qi < 2; ++qi)
#pragma unroll
            for (int ks = 0; ks < 4; ++ks) qf[qi][ks] = *(const LAS bf16x8*)(stg + 4096 * qi + off64(j, 2 * ks + h));
        f32x16 o[2][2];
#pragma unroll
        for (int qi = 0; qi < 2; ++qi)
#pragma unroll
            for (int c = 0; c < 2; ++c)
#pragma unroll
                for (int r = 0; r < 16; ++r) o[qi][c][r] = 0.f;
        float mrun[2] = {sink, sink}, lsum[2] = {h == 0 ? 1.f : 0.f, h == 0 ? 1.f : 0.f};
        for (int kt = kt_hi; kt >= kt_lo; --kt) swa_tile(KV + kt * 8192, KV + kt * 8192 + 4096, kt, sample, slope2, cr, lane, qf, o, mrun, lsum);
        WG_BAR();
        const int un = u + F.G;
        if (un < NU) fill(un);
        { const char* qb = (const char*)(PROJ + m0 * 4608 + hq * 64);
          dma_tile64(stg, qb + 5120, voff); dma_tile64(stg + 4096, qb + 5120 + (sample ? 0 : 294912), voff); }
        VMW(0); SCHEDB();
#pragma unroll
        for (int qi = 0; qi < 2; ++qi) {
            const float inv = 1.0f / (lsum[qi] + __shfl_xor(lsum[qi], 32));
#pragma unroll
            for (int c = 0; c < 2; ++c)
#pragma unroll
                for (int g = 0; g < 4; ++g) { const unsigned a = 4096 * qi + off64(j, 4 * c + g) + 8 * h; const u32x2v gv = *(const LAS u32x2v*)(stg + a);
                    u32x2v ov; ov.x = cvtpk(o[qi][c][4 * g] * inv * silu_fast(bflo(gv.x)), o[qi][c][4 * g + 1] * inv * silu_fast(bfhi(gv.x))); ov.y = cvtpk(o[qi][c][4 * g + 2] * inv * silu_fast(bflo(gv.y)), o[qi][c][4 * g + 3] * inv * silu_fast(bfhi(gv.y)));
                    *(LAS u32x2v*)(stg + a) = ov; }
        }
        LGW0();
        { const unsigned ob = ((unsigned)m0 * 2048u + (unsigned)hq * 64u) * 2u;
#pragma unroll
          for (int qi = 0; qi < 2; ++qi) {
              if (sample && qi == 1) break;
#pragma unroll
              for (int i = 0; i < 4; ++i) { const v4u x = *(const LAS v4u*)(stg + 4096 * qi + off64(srow + 8 * i, sch)); __builtin_amdgcn_raw_buffer_store_b128(x, rsO, (int)vso, (int)(ob + qi * 131072 + i * 32768), 0); } } }
        LGW0();
        if (un < NU) qfill(un);
    }
    WG_BAR();
}
__device__ __forceinline__ void swa_attn_mfma(Frame& F, const bf16* PROJ, const float* cache_k, const float* cache_v, const float* sinks, bf16* AO) {
    swa_attn_wg(F, PROJ, cache_k, cache_v, sinks, AO);
}

template <bool FULL>
__device__ __forceinline__ void s5_unit_mfma(Frame& F, const Ptrs& P, const bf16* PROJ, bf16* Y1, size_t row0, int NT, int g, float& hr, float& hi,
                                             const bf16x8 (&bfr)[4], const bf16x8 (&cfr)[8], float lr, float li, const f32x4 (&dd)[2]) {
    LAS unsigned char* img = F.lds + RING_OFF + F.wave * 16384;
    const int lane = F.lane, j = lane & 31, h = lane >> 5;
    bf16x8 ufn = *(const GAS bf16x8*)(PROJ + (row0 + j) * 2048 + g * 16 + 8 * h);
    for (int mt = 0; mt < NT; ++mt) {
        const bf16x8 uf = ufn;
        if (mt + 1 < NT) ufn = *(const GAS bf16x8*)(PROJ + (row0 + 32 * (mt + 1) + j) * 2048 + g * 16 + 8 * h);
        f32x16 z16;
#pragma unroll
        for (int r = 0; r < 16; ++r) z16[r] = 0.f;
        LGW0();
#pragma unroll
        for (int pt = 0; pt < 4; ++pt) { const f32x16 bu = MFMA32(uf, bfr[pt], z16);
#pragma unroll
            for (int r = 0; r < 16; ++r) { const int t = (r & 3) + 8 * (r >> 2) + 4 * h; *(LAS float*)(img + 512 * t + 4 * (32 * pt + j)) = bu[r]; } }
        LGW0();
#pragma unroll
        for (int t = 0; t < 32; ++t) {
            const float bur = *(const LAS float*)(img + 512 * t + 4 * lane), bui = *(const LAS float*)(img + 512 * t + 256 + 4 * lane);
            const float nr = lr * hr - li * hi + bur, ni = lr * hi + li * hr + bui; hr = nr; hi = ni;
            if (FULL) { const unsigned a0 = 512 * t + 16 * ((lane >> 3) ^ (t & 15)) + 2 * (lane & 7), a1 = 512 * t + 16 * ((8 + (lane >> 3)) ^ (t & 15)) + 2 * (lane & 7);
                *(LAS unsigned short*)(img + a0) = (unsigned short)f2bf(hr); *(LAS unsigned short*)(img + a1) = (unsigned short)f2bf(hi); }
        }
        if (FULL) {
            LGW0();
            f32x16 y = z16;
#pragma unroll
            for (int ks = 0; ks < 8; ++ks) { const bf16x8 hf = *(const LAS bf16x8*)(img + 512 * j + 16 * ((2 * ks + h) ^ (j & 15))); y = MFMA32(hf, cfr[ks], y); }
#pragma unroll
            for (int r = 0; r < 16; ++r) { const int t = (r & 3) + 8 * (r >> 2) + 4 * h; *(LAS float*)(img + 512 * t + 256 + 4 * j) = y[r]; }
            LGW0();
            const f32x4 y0 = *(const LAS f32x4*)(img + 512 * j + 256 + 32 * h), y1 = *(const LAS f32x4*)(img + 512 * j + 256 + 32 * h + 16);
            const v4u uw = __builtin_bit_cast(v4u, uf);
            f32x4 r0, r1;
            r0.x = gelu_tanh_f(y0.x + dd[0].x * bflo(uw.x)); r0.y = gelu_tanh_f(y0.y + dd[0].y * bfhi(uw.x)); r0.z = gelu_tanh_f(y0.z + dd[0].z * bflo(uw.y)); r0.w = gelu_tanh_f(y0.w + dd[0].w * bfhi(uw.y));
            r1.x = gelu_tanh_f(y1.x + dd[1].x * bflo(uw.z)); r1.y = gelu_tanh_f(y1.y + dd[1].y * bfhi(uw.z)); r1.z = gelu_tanh_f(y1.z + dd[1].z * bflo(uw.w)); r1.w = gelu_tanh_f(y1.w + dd[1].w * bfhi(uw.w));
            *(GAS v4u*)(Y1 + (row0 + 32 * mt + j) * 1024 + g * 16 + 8 * h) = pack8(r0, r1);
        }
    }
}
struct S5Consts { bf16x8 bfr[4]; bf16x8 cfr[8]; float lr, li; f32x4 dd[2]; };
template <bool FULL>
__device__ __forceinline__ void s5_load_consts(Frame& F, const Ptrs& P, int g, bf16x8 (&bfr)[4], bf16x8 (&cfr)[8], float& lr, float& li, f32x4 (&dd)[2]) {
    const int lane = F.lane, j = lane & 31, h = lane >> 5;
    const bf16* BBb = (const bf16*)(P.ws + WS_BBB); const bf16* Cmb = (const bf16*)(P.ws + WS_CMB);
    const float* lam = (const float*)(P.ws + WS_SSMC);
#pragma unroll
    for (int pt = 0; pt < 4; ++pt) bfr[pt] = *(const GAS bf16x8*)(BBb + ((size_t)g * 128 + 32 * pt + j) * 16 + 8 * h);
    lr = lam[2 * (g * 64 + lane)]; li = lam[2 * (g * 64 + lane) + 1];
    if (FULL) {
        const bf16x8 zero8 = {0, 0, 0, 0, 0, 0, 0, 0};
#pragma unroll
        for (int ks = 0; ks < 8; ++ks) { const bf16x8 v = *(const GAS bf16x8*)(Cmb + ((size_t)g * 16 + (j & 15)) * 128 + 16 * ks + 8 * h); cfr[ks] = (j < 16) ? v : zero8; }
        dd[0] = *(const GAS f32x4*)(P.in[23] + g * 16 + 8 * h); dd[1] = *(const GAS f32x4*)(P.in[23] + g * 16 + 8 * h + 4);
    }
}
__device__ __forceinline__ void s5_local_mfma(Frame& F, const Ptrs& P, const bf16* PROJ) {
    float* SEND = (float*)(P.ws + WS_SEND);
    for (int vw = F.vcu * NWAVES + F.wave; vw < 2048; vw += F.G * NWAVES) {
        const int g = vw & 63, seg = vw >> 6;
        bf16x8 bfr[4], cfr[8]; float lr, li; f32x4 dd[2];
        s5_load_consts<false>(F, P, g, bfr, cfr, lr, li, dd);
        float hr = 0.f, hi = 0.f;
        s5_unit_mfma<false>(F, P, PROJ, nullptr, (size_t)seg * 1024, 32, g, hr, hi, bfr, cfr, lr, li, dd);
        SEND[((size_t)seg * 64 + g) * 128 + F.lane] = hr; SEND[((size_t)seg * 64 + g) * 128 + 64 + F.lane] = hi;
    }
}
__device__ __forceinline__ void s5_carry_seg(Frame& F, const Ptrs& P) {
    for (int gt = F.vcu * (NWAVES * 64) + F.tid; gt < 2 * 64 * 64; gt += F.G * NWAVES * 64) {
    const int b = gt >> 12, gp = gt & 4095, g = gp >> 6, p = gp & 63;
    const float* SEND = (const float*)(P.ws + WS_SEND); float* HIN = (float*)(P.ws + WS_HIN);
    const float* lam64 = (const float*)(P.ws + WS_SSMC) + 64 * 64 * 2;
    float lr = lam64[2 * gp], li = lam64[2 * gp + 1];
#pragma unroll
    for (int i = 0; i < 4; ++i) { const float nr = lr * lr - li * li, ni = 2.0f * lr * li; lr = nr; li = ni; }
    float sr[16], si[16];
#pragma unroll
    for (int s = 0; s < 16; ++s) { const size_t o = (((size_t)b * 16 + s) * 64 + g) * 128 + p; sr[s] = SEND[o]; si[s] = SEND[o + 64]; }
    float hr = 0.f, hi = 0.f;
#pragma unroll
    for (int s = 0; s < 16; ++s) { const size_t o = (((size_t)b * 16 + s) * 64 + g) * 128 + p; HIN[o] = hr; HIN[o + 64] = hi;
        const float nr = lr * hr - li * hi + sr[s], ni = lr * hi + li * hr + si[s]; hr = nr; hi = ni; }
    P.out[O_HRP + (size_t)b * 4096 + gp] = hr; P.out[O_HIP + (size_t)b * 4096 + gp] = hi;
    }
}
__device__ __forceinline__ void s5_full_mfma(Frame& F, const Ptrs& P, const bf16* PROJ, bf16* Y1) {
    const float* SEND = (const float*)(P.ws + WS_SEND);
    const float* lam64 = (const float*)(P.ws + WS_SSMC) + 64 * 64 * 2;
    for (int vw = F.vcu * NWAVES + F.wave; vw < 2048; vw += F.G * NWAVES) {
    const int g = vw & 63, seg = vw >> 6;
    float hin_r, hin_i;
    { const int cb = seg >> 4, cs = seg & 15, gp = g * 64 + F.lane;
      float cr = lam64[2 * gp], ci = lam64[2 * gp + 1];
#pragma unroll
      for (int i = 0; i < 4; ++i) { const float nr = cr * cr - ci * ci, ni = 2.0f * cr * ci; cr = nr; ci = ni; }
      float sr[16], si[16];
#pragma unroll
      for (int j = 0; j < 16; ++j) { const size_t o = (((size_t)cb * 16 + j) * 64 + g) * 128 + F.lane; sr[j] = SEND[o]; si[j] = SEND[o + 64]; }
      float hr = 0.f, hi = 0.f;
#pragma unroll
      for (int j = 0; j < 15; ++j) { const float nr = cr * hr - ci * hi + sr[j], ni = cr * hi + ci * hr + si[j]; const bool act = j < cs; hr = act ? nr : hr; hi = act ? ni : hi; }
      hin_r = hr; hin_i = hi;
      if (cs == 15) { const float nr = cr * hr - ci * hi + sr[15], ni = cr * hi + ci * hr + si[15]; P.out[O_HRP + (size_t)cb * 4096 + gp] = nr; P.out[O_HIP + (size_t)cb * 4096 + gp] = ni; } }
    bf16x8 bfr[4], cfr[8]; float lr, li; f32x4 dd[2];
    s5_load_consts<true>(F, P, g, bfr, cfr, lr, li, dd);
    { float hr = hin_r, hi = hin_i;
      s5_unit_mfma<true>(F, P, PROJ, Y1, (size_t)seg * 1024, 32, g, hr, hi, bfr, cfr, lr, li, dd); }
    { const int b = seg;
      float hr = P.in[6][((size_t)b * 64 + g) * 64 + F.lane], hi = P.in[7][((size_t)b * 64 + g) * 64 + F.lane];
      s5_unit_mfma<true>(F, P, PROJ, Y1, (size_t)MP + b * 32, 1, g, hr, hi, bfr, cfr, lr, li, dd);
      P.out[O_HRS + ((size_t)b * 64 + g) * 64 + F.lane] = hr; P.out[O_HIS + ((size_t)b * 64 + g) * 64 + F.lane] = hi; }
    }
}
constexpr int N_PHASES = 20;
#ifndef MK_PER_PHASE
#define MK_PER_PHASE 0
#endif
#ifndef GEMM_SP2
#define GEMM_SP2 true
#endif
#ifndef ALIGNE
#define ALIGNE true
#endif
constexpr int CW_FLOW = 8192;
template <class Epi>
__device__ __forceinline__ void gemm_parts(Frame& F, XcdBarrier& bar, const pg8::Gemm& g, const Epi& E, int N, int bx, int rot, bool midbar, unsigned* wset, unsigned wneed, unsigned* sset) {
    for (int part = 0; part < 2; ++part) {
        pg8::StaticOrder S;
        if (part == 0) S.init_part(NPM_P, 0, N, F.G, bx); else S.init_part(NPM - NPM_P, NPM_P, N, F.G, (bx + F.G - rot % F.G) % F.G);
        if (part == 1 && midbar) xcd_barrier(bar);
        pg8::Unit u0; if (!S.next(0, u0)) continue;
        if (part == 1 && wset) {
            if (F.tid == 0) { unsigned sp = 0;
                while (__hip_atomic_load(wset, __ATOMIC_RELAXED, __HIP_MEMORY_SCOPE_AGENT) < wneed) { __builtin_amdgcn_s_sleep(2); if (++sp > (1u << 22)) break; }
                __builtin_amdgcn_fence(__ATOMIC_ACQUIRE, "agent"); }
            __syncthreads();
        }
#ifdef DELAY_SAMPLE
        if (part == 1 && sset) { const unsigned long long ti = __builtin_amdgcn_s_memrealtime(); while (__builtin_amdgcn_s_memrealtime() - ti < (unsigned long long)(DELAY_SAMPLE) * 100ull) __builtin_amdgcn_s_sleep(32); }
#endif
        pg8::gemm_phase<Epi, pg8::StaticOrder, ALIGNE, GEMM_SP2>(F.lds + RING_OFF, g, S, E);
        if (part == 1 && sset && F.tid == 0) { __threadfence(); unsigned n = 0; pg8::Unit u; for (int i = 0; S.next(i, u); ++i) ++n; __hip_atomic_fetch_add(sset, n, __ATOMIC_RELAXED, __HIP_MEMORY_SCOPE_AGENT); }
    }
}
__global__ void __launch_bounds__(NWAVES * 64, 2) enc_fwd(Ptrs P) {
    extern __shared__ __attribute__((aligned(16))) unsigned char lds[];
    Frame F;
    F.lds = (LAS unsigned char*)lds;
    F.MISC = (volatile LAS unsigned*)(F.lds + MISC_OFF);
    F.tid = threadIdx.x; F.lane = F.tid & 63; F.wave = __builtin_amdgcn_readfirstlane(F.tid >> 6);
    F.G = gridDim.x; { const int bx = blockIdx.x; F.vcu = (F.G % 8 == 0) ? (bx % 8) * (F.G / 8) + bx / 8 : bx; }
    unsigned char* ws = P.ws;
    F.ctl = (gu32*)(ws + WS_CTL);
    for (int u = F.tid; u < (LDS_BYTES - LDSCTL_OFF) / 4; u += NWAVES * 64) ((LAS unsigned*)(F.lds + LDSCTL_OFF))[u] = 0u;
    __syncthreads();
    XcdBarrier bar; bar.bar = (unsigned*)(F.ctl + CW_BAR); bar.x = 0; bar.st = nullptr;
    if (!MK_PER_PHASE) bar = xcd_barrier_post((unsigned*)(F.ctl + CW_BAR), F.MISC + 8);
    const int lo = P.ph_lo, hi = P.ph_hi;
#define IN(k) (lo <= (k) && (k) < hi)
#define SEAM(k) do { if (IN(k) && IN((k) + 1)) xcd_barrier(bar); } while (0)
#define PHASE(k) if (IN(k))
    float* const C1C2 = (float*)(ws + WS_C1C2); float* const ST = (float*)(ws + WS_STATS);
    bf16* const XB = (bf16*)(ws + WS_XB); float* const XF = (float*)(ws + WS_XF); bf16* const PROJ = (bf16*)(ws + WS_PROJ); bf16* const AO = (bf16*)(ws + WS_AO); bf16* const AOC = (bf16*)(ws + WS_AOC);
    const int bx = (int)blockIdx.x;
    unsigned* const FL = (unsigned*)(F.ctl + CW_FLOW);
    constexpr int NS = NPM - NPM_P;

    PHASE(0) { p0_prologue(F, P); } SEAM(0);
    PHASE(1) { pg8::Gemm g{XB, (const bf16*)(ws + WS_WINA0), M, 4096, 2048}; pg8::StaticOrder S; S.init(M, 4096, F.G, bx);
        pg8::EpiProjA<false> E{PROJ, P.out + O_KAP, P.out + O_VAP, P.out + O_KAS, P.out + O_VAS, pg8::RowAff{nullptr, nullptr, nullptr, nullptr}};
        pg8::gemm_phase<pg8::EpiProjA<false>, pg8::StaticOrder, ALIGNE, GEMM_SP2>(F.lds + RING_OFF, g, S, E);
        { const int nt = (NPM * 16) % F.G;
          if (nt > 0 && bx >= nt) { p0_weights(F, P, PW_R0, PW_R1, (bx - nt) * NWAVES + F.wave, (F.G - nt) * NWAVES); p0_s5tables(P, (bx - nt) * (NWAVES * 64) + F.tid, (F.G - nt) * (NWAVES * 64)); }
          else if (nt == 0) { p0_weights(F, P, PW_R0, PW_R1, bx * NWAVES + F.wave, F.G * NWAVES); p0_s5tables(P, bx * (NWAVES * 64) + F.tid, F.G * (NWAVES * 64)); } } } SEAM(1);
    PHASE(2) { sb_attn_mfma(F, PROJ, P.in[2], P.in[3], AO, 16); } SEAM(2);
    PHASE(3) { pg8::Gemm g{AO, (const bf16*)(ws + WS_WOUTA0), M, 2048, 1024};
        pg8::EpiResidB<false, false, true> E{XB, XB, nullptr, nullptr, nullptr, nullptr, nullptr, ST, ST + M};
        gemm_parts(F, bar, g, E, 2048, bx, 0, true, nullptr, 0u, FL); }
    PHASE(5) { pg8::Gemm g{XB, (const bf16*)(ws + WS_WINB), M, 4608, 2048};
        pg8::EpiProjB E{PROJ, P.out, pg8::RowAff{ST, ST + M, C1C2, C1C2 + 4608}};
        gemm_parts(F, bar, g, E, 4608, bx, NS * 8, false, FL, (unsigned)(NS * 8), nullptr);
        { const int c5 = (bx + F.G - (NS * 8) % F.G) % F.G, nt = NS * 18, nf = F.G - nt - NS * 8;
          if (nf > 0) { if (c5 >= nt && c5 < nt + nf) p0_weights(F, P, PW_R1, PW_R2, (c5 - nt) * NWAVES + F.wave, nf * NWAVES); }
          else p0_weights(F, P, PW_R1, PW_R2, bx * NWAVES + F.wave, F.G * NWAVES); } } SEAM(5);
    PHASE(6) { swa_attn_mfma(F, PROJ, P.in[4], P.in[5], P.in[13], AO); } SEAM(6);
    PHASE(7) { pg8::Gemm g{AO, (const bf16*)(ws + WS_WOUTB), M, 2048, 2048};
        pg8::EpiResidB<false, true, true> E{XB, XB, nullptr, ST, ST + M, P.in[8], P.in[9], ST + 2 * M, ST + 3 * M};
        gemm_parts(F, bar, g, E, 2048, bx, 0, true, nullptr, 0u, FL + 64); }
    PHASE(9) { pg8::Gemm g{XB, (const bf16*)(ws + WS_WINC), M, 2048, 2048};
        pg8::EpiProjC E{PROJ, pg8::RowAff{ST + 2 * M, ST + 3 * M, C1C2 + 2 * 4608, C1C2 + 3 * 4608}};
        gemm_parts(F, bar, g, E, 2048, bx, NS * 8, false, FL + 64, (unsigned)(NS * 8), nullptr); } SEAM(9);
    PHASE(10) { s5_local_mfma(F, P, PROJ); } SEAM(10);
    PHASE(12) { s5_full_mfma(F, P, PROJ, AO); } SEAM(12);
    PHASE(13) { pg8::Gemm g{AO, (const bf16*)(ws + WS_WGLU), M, 1024, 1024};
        pg8::EpiGlu E{AO, PROJ, AOC};
        gemm_parts(F, bar, g, E, 1024, bx, 0, true, nullptr, 0u, FL + 128); }
    PHASE(14) { pg8::Gemm g{AOC, (const bf16*)(ws + WS_WOUTC), M, 2048, 1024};
        pg8::EpiResidB<false, true, true> E{XB, XB, nullptr, ST + 2 * M, ST + 3 * M, P.in[8] + DM, P.in[9] + DM, ST + 4 * M, ST + 5 * M};
        gemm_parts(F, bar, g, E, 2048, bx, NS * 4, true, FL + 128, (unsigned)(NS * 4), FL + 192); }
    PHASE(16) { pg8::Gemm g{XB, (const bf16*)(ws + WS_WINA1), M, 4096, 2048};
        pg8::EpiProjA<true> E{PROJ, P.out + O_KAP + (size_t)MP * 1024, P.out + O_VAP + (size_t)MP * 1024, P.out + O_KAS + (size_t)MS * 1024, P.out + O_VAS + (size_t)MS * 1024, pg8::RowAff{ST + 4 * M, ST + 5 * M, C1C2 + 4 * 4608, C1C2 + 5 * 4608}};
        gemm_parts(F, bar, g, E, 4096, bx, NS * 12, false, FL + 192, (unsigned)(NS * 8), nullptr); } SEAM(16);
    PHASE(17) { sb_attn_mfma(F, PROJ, P.in[2] + (size_t)DECB * PAST * 1024, P.in[3] + (size_t)DECB * PAST * 1024, AO, 17); } SEAM(17);
    PHASE(18) { pg8::Gemm g{AO, (const bf16*)(ws + WS_WOUTA1), M, 2048, 1024};
        pg8::EpiResidB<false, true, true> E{XB, XB, nullptr, ST + 4 * M, ST + 5 * M, P.in[8] + 2 * DM, P.in[9] + 2 * DM, ST + 6 * M, ST + 7 * M};
        gemm_parts(F, bar, g, E, 2048, bx, 0, true, nullptr, 0u, FL + 256); }
    PHASE(19) { const int nsu = NS * 8, nS = nsu < F.G ? nsu : 0;
        if (nS > 0 && bx >= nS) ln_phase_final(F, XB, ST + 6 * M, ST + 7 * M, P.out + O_YP, P.in[8] + 3 * DM, P.in[9] + 3 * DM, 0, MP, (bx - nS) * NWAVES + F.wave, (F.G - nS) * NWAVES);
        else {
            if (F.tid == 0) { unsigned sp = 0; while (__hip_atomic_load(FL + 256, __ATOMIC_RELAXED, __HIP_MEMORY_SCOPE_AGENT) < (unsigned)nsu) { __builtin_amdgcn_s_sleep(2); if (++sp > (1u << 22)) break; }
                __builtin_amdgcn_fence(__ATOMIC_ACQUIRE, "agent"); }
            __syncthreads();
            if (nS > 0) ln_phase_final(F, XB, ST + 6 * M, ST + 7 * M, P.out + O_YP, P.in[8] + 3 * DM, P.in[9] + 3 * DM, MP, M, bx * NWAVES + F.wave, nS * NWAVES);
            else ln_phase_final(F, XB, ST + 6 * M, ST + 7 * M, P.out + O_YP, P.in[8] + 3 * DM, P.in[9] + 3 * DM, 0, M, F.vcu * NWAVES + F.wave, F.G * NWAVES); } }
#undef IN
#undef SEAM
}

extern "C" void kernel_launch(void* const* d_in, const int* in_sizes, int n_in, void* d_out, int out_size, void* d_ws, size_t ws_size, hipStream_t stream) {
    static int grid = 0;
    if (grid == 0) {
        if (n_in != 26 || (size_t)out_size != O_END || ws_size < WS_END) { fprintf(stderr, "kernel_launch: unexpected shapes: n_in %d out %d (want %zu) ws %zu (want >= %zu); nothing launched\n", n_in, out_size, (size_t)O_END, ws_size, (size_t)WS_END); grid = -1; return; }
        int dev = 0, cus = 0, per_cu = 0;
        if (hipGetDevice(&dev) != hipSuccess || hipDeviceGetAttribute(&cus, hipDeviceAttributeMultiprocessorCount, dev) != hipSuccess) { fprintf(stderr, "kernel_launch: device query failed\n"); grid = -1; return; }
        if (hipFuncSetAttribute((const void*)enc_fwd, hipFuncAttributeMaxDynamicSharedMemorySize, LDS_BYTES) != hipSuccess) { fprintf(stderr, "kernel_launch: hipFuncSetAttribute failed\n"); grid = -1; return; }
        if (hipOccupancyMaxActiveBlocksPerMultiprocessor(&per_cu, (const void*)enc_fwd, NWAVES * 64, LDS_BYTES) != hipSuccess || per_cu < 1)
            fprintf(stderr, "kernel_launch: note: occupancy query reports %d workgroups per CU\n", per_cu);
        (void)hipGetLastError();
        grid = cus;
    }
    if (grid < 0) return;
    if (hipMemsetAsync((char*)d_ws + WS_CTL, 0, CTL_ZERO_BYTES, stream) != hipSuccess) { fprintf(stderr, "kernel_launch: memset failed\n"); return; }
    Ptrs a{};
    for (int i = 0; i < 26; ++i) a.in[i] = (const float*)d_in[i];
    a.out = (float*)d_out; a.ws = (unsigned char*)d_ws;
#if MK_PER_PHASE
    for (int ph = 0; ph < N_PHASES; ++ph) { a.ph_lo = ph; a.ph_hi = ph + 1; hipLaunchKernelGGL(enc_fwd, dim3(grid), dim3(NWAVES * 64), LDS_BYTES, stream, a); }
#else
    a.ph_lo = 0; a.ph_hi = N_PHASES;
    hipLaunchKernelGGL(enc_fwd, dim3(grid), dim3(NWAVES * 64), LDS_BYTES, stream, a);
#endif
    const hipError_t le = hipPeekAtLastError();
    if (le != hipSuccess) fprintf(stderr, "kernel_launch: launch failed: %s\n", hipGetErrorName(le));
}
```
